# Optimizing an MI355X kernel written in HIP

```python
import math
import jax, jax.numpy as jnp
from jax import lax
import numpy as np

D_MODEL = 1024
BATCH = 16
SEQ = 4096
DEPTH = 1
DEC_BATCH = 4
DEC_SEQ = 4096
PAST_LEN = 128

PLE_DIM = 256
M_HEADS = 4
M_QK = 128
M_V = 256
M_CHUNK = 64
M_CONV = 5
A_HEADS = 8
A_NOPE = 128
A_ROPE = 64
A_V = 128
Q_LORA = 256
KV_LORA = 256
ROPE_THETA = 10000.0
Q_BLOCK = 128
D_FF = -(-(8 * D_MODEL) // (3 * 256)) * 256
EPS = 1e-6

M_QK_W = 2 * M_HEADS * M_QK
M_V_W = M_HEADS * M_V
M_GATE_W = 4 * M_HEADS
MERGE_W = 2 * D_MODEL
IN_SIZES = (M_QK_W, M_V_W, M_V_W, M_GATE_W, Q_LORA, KV_LORA, A_ROPE, MERGE_W)
IN_W = M_QK_W + 2 * M_V_W + M_GATE_W + Q_LORA + KV_LORA + A_ROPE + MERGE_W

kernel_name = "hybrid_mlstm_mla_encoder"


def _offsets(sizes):
    out, acc = [], 0
    for s in sizes[:-1]:
        acc += s
        out.append(acc)
    return out


def rmsnorm(x, g):
    xf = x.astype(jnp.float32)
    y = xf * lax.rsqrt(jnp.mean(xf * xf, axis=-1, keepdims=True) + EPS)
    return (y * g.astype(jnp.float32)).astype(x.dtype)


def rope(x, cos, sin):
    x1, x2 = jnp.split(x, 2, axis=-1)
    cos = cos.astype(x.dtype)
    sin = sin.astype(x.dtype)
    return jnp.concatenate([x1 * cos - x2 * sin, x1 * sin + x2 * cos], axis=-1)


def centred_conv(u, w):
    S = u.shape[1]
    half = M_CONV // 2
    up = jnp.pad(u, ((0, 0), (half, half), (0, 0)))
    out = up[:, 0:S] * w[0]
    for j in range(1, M_CONV):
        out = out + up[:, j:j + S] * w[j]
    return out


def mlstm_chunkwise(q, k, v, log_i, log_f):
    q, k, v, log_i, log_f = (a.astype(jnp.float32) for a in (q, k, v, log_i, log_f))
    B, H, S, DK = q.shape
    DV = v.shape[-1]
    L = M_CHUNK
    NC = S // L

    def to_chunks(a):
        return jnp.moveaxis(a.reshape(B, H, NC, L, *a.shape[3:]), 2, 0)

    qc, kc, vc, ic, fc = (to_chunks(a) for a in (q, k, v, log_i, log_f))
    tri = jnp.tril(jnp.ones((L, L), dtype=bool))

    def step(carry, inp):
        C, n, m = carry
        qb, kb, vb, ib, fb = inp
        b = jnp.cumsum(fb, axis=-1)
        d_intra = jnp.where(tri, b[..., :, None] - b[..., None, :] + ib[..., None, :], -jnp.inf)
        d_inter = b + m[..., None]
        m_comb = jnp.maximum(d_inter, jnp.max(d_intra, axis=-1))
        w_intra = jnp.exp(d_intra - m_comb[..., None])
        w_inter = jnp.exp(d_inter - m_comb)
        s = jnp.einsum('bhtd,bhsd->bhts', qb, kb) * w_intra
        num = jnp.einsum('bhts,bhsv->bhtv', s, vb) + w_inter[..., None] * jnp.einsum('bhtd,bhdv->bhtv', qb, C)
        den = jnp.sum(s, axis=-1) + w_inter * jnp.einsum('bhtd,bhd->bht', qb, n)
        h = num / jnp.maximum(jnp.abs(den), jnp.exp(-m_comb))[..., None]
        b_last = b[..., -1]
        g = b_last[..., None] - b + ib
        m_new = jnp.maximum(b_last + m, jnp.max(g, axis=-1))
        a_prev = jnp.exp(b_last + m - m_new)
        ka = kb * jnp.exp(g - m_new[..., None])[..., None]
        C_new = a_prev[..., None, None] * C + jnp.einsum('bhsd,bhsv->bhdv', ka, vb)
        n_new = a_prev[..., None] * n + jnp.sum(ka, axis=2)
        return (C_new, n_new, m_new), h

    init = (jnp.zeros((B, H, DK, DV), jnp.float32), jnp.zeros((B, H, DK), jnp.float32),
            jnp.zeros((B, H), jnp.float32))
    _, hs = lax.scan(step, init, (qc, kc, vc, ic, fc))
    return jnp.moveaxis(hs, 0, 2).reshape(B, H, S, DV)


def mla_attention(q_nope, q_rope, k_nope, k_rope, v):
    B, S, H, _ = q_nope.shape
    nb = S // Q_BLOCK
    scale = (A_NOPE + A_ROPE) ** -0.5

    def blocks(a):
        return jnp.moveaxis(a.reshape(B, nb, Q_BLOCK, *a.shape[2:]), 1, 0)

    def one(args):
        qn, qr = args
        s = jnp.einsum('bqhd,bkhd->bhqk', qn, k_nope) + jnp.einsum('bqhr,bkr->bhqk', qr, k_rope)
        p = jax.nn.softmax(s.astype(jnp.float32) * scale, axis=-1).astype(v.dtype)
        return jnp.einsum('bhqk,bkhd->bqhd', p, v)

    o = lax.map(one, (blocks(q_nope), blocks(q_rope)))
    return jnp.moveaxis(o, 0, 1).reshape(B, S, H * A_V)


def encoder_layer(x, p_l, g_mix, w_in, b_gate, conv_w, g_mhead, w_mo, g_q, w_uq, g_kv, w_ukv,
                  w_ao, w_out, g_ffn, w_gate, w_up, w_down, w_ple, w_ple_gate):
    B, S, _ = x.shape
    pos = jnp.arange(S, dtype=jnp.float32)
    inv_freq = ROPE_THETA ** (-jnp.arange(0, A_ROPE, 2, dtype=jnp.float32) / A_ROPE)
    ang = pos[:, None] * inv_freq[None, :]
    cos, sin = jnp.cos(ang), jnp.sin(ang)

    h = rmsnorm(x, g_mix)
    u = h @ w_in
    qk, v, o, gates, c_q, c_kv, k_r, gm = jnp.split(u, _offsets(IN_SIZES), axis=-1)

    qk = jax.nn.silu(centred_conv(qk, conv_w))
    q, k = jnp.split(qk, 2, axis=-1)
    q = q.reshape(B, S, M_HEADS, M_QK).transpose(0, 2, 1, 3) * (M_QK ** -0.5)
    k = k.reshape(B, S, M_HEADS, M_QK).transpose(0, 2, 1, 3)
    vh = v.reshape(B, S, M_HEADS, M_V).transpose(0, 2, 1, 3)
    gates = (gates + b_gate).astype(jnp.float32).reshape(B, S, 4, M_HEADS).transpose(0, 2, 3, 1)
    log_i = jnp.concatenate([gates[:, 0], jnp.flip(gates[:, 1], axis=-1)], axis=1)
    log_f = jax.nn.log_sigmoid(jnp.concatenate([gates[:, 2], jnp.flip(gates[:, 3], axis=-1)], axis=1))
    both = lambda a: jnp.concatenate([a, jnp.flip(a, axis=2)], axis=1)
    hm = mlstm_chunkwise(both(q), both(k), both(vh), log_i, log_f)
    hm = hm[:, :M_HEADS] + jnp.flip(hm[:, M_HEADS:], axis=2)
    hm = rmsnorm(hm.transpose(0, 2, 1, 3), g_mhead.reshape(M_HEADS, M_V)).reshape(B, S, M_V_W)
    y_m = (jax.nn.sigmoid(o) * hm.astype(x.dtype)) @ w_mo

    qa = (rmsnorm(c_q, g_q) @ w_uq).reshape(B, S, A_HEADS, A_NOPE + A_ROPE)
    q_nope = qa[..., :A_NOPE]
    q_rope = rope(qa[..., A_NOPE:], cos[:, None, :], sin[:, None, :])
    kv = (rmsnorm(c_kv, g_kv) @ w_ukv).reshape(B, S, A_HEADS, A_NOPE + A_V)
    k_nope, va = kv[..., :A_NOPE], kv[..., A_NOPE:]
    k_rope = rope(k_r, cos, sin)
    y_a = mla_attention(q_nope, q_rope, k_nope, k_rope, va) @ w_ao

    g_m, g_a = jnp.split(jax.nn.sigmoid(gm), 2, axis=-1)
    x = x + (g_m * y_m + g_a * y_a) @ w_out

    h2 = rmsnorm(x, g_ffn)
    x = x + (jax.nn.silu(h2 @ w_gate) * (h2 @ w_up)) @ w_down

    x = x + jax.nn.sigmoid(x @ w_ple_gate) * (p_l @ w_ple)
    return x


def encoder(x, p, g_mix, w_in, b_gate, conv_w, g_mhead, w_mo, g_q, w_uq, g_kv, w_ukv, w_ao,
            w_out, g_ffn, w_gate, w_up, w_down, w_ple, w_ple_gate, g_final):
    for i in range(DEPTH):
        x = encoder_layer(x, p[i], g_mix[i], w_in[i], b_gate[i], conv_w[i], g_mhead[i], w_mo[i],
                          g_q[i], w_uq[i], g_kv[i], w_ukv[i], w_ao[i], w_out[i], g_ffn[i],
                          w_gate[i], w_up[i], w_down[i], w_ple[i], w_ple_gate[i])
    return rmsnorm(x, g_final)


def setup_inputs(seed: int = 0) -> dict:
    key = jax.random.key(seed)
    ks = jax.random.split(key, 32)

    def nrm(k, shape, scale):
        return jax.random.normal(k, shape, jnp.float32) * scale

    def gain(k, shape):
        return 1.0 + 0.05 * jax.random.normal(k, shape, jnp.float32)

    i_bias = nrm(ks[10], (DEPTH, 2 * M_HEADS), 0.1)
    f_bias = 3.0 + nrm(ks[11], (DEPTH, 2 * M_HEADS), 0.5)
    return {
        "x_prompt": nrm(ks[0], (BATCH, SEQ, D_MODEL), 1.0),
        "x_sample": nrm(ks[1], (DEC_BATCH, DEC_SEQ, D_MODEL), 1.0),
        "p_prompt": nrm(ks[2], (DEPTH, BATCH, SEQ, PLE_DIM), 1.0),
        "p_sample": nrm(ks[3], (DEPTH, DEC_BATCH, DEC_SEQ, PLE_DIM), 1.0),
        "g_mix": gain(ks[4], (DEPTH, D_MODEL)),
        "w_in": nrm(ks[5], (DEPTH, D_MODEL, IN_W), D_MODEL ** -0.5),
        "b_gate": jnp.concatenate([i_bias, f_bias], axis=-1),
        "conv_w": nrm(ks[6], (DEPTH, M_CONV, M_QK_W), M_CONV ** -0.5),
        "g_mhead": gain(ks[7], (DEPTH, M_V_W)),
        "w_mo": nrm(ks[8], (DEPTH, M_V_W, D_MODEL), M_V_W ** -0.5),
        "g_q": gain(ks[9], (DEPTH, Q_LORA)),
        "w_uq": nrm(ks[12], (DEPTH, Q_LORA, A_HEADS * (A_NOPE + A_ROPE)), Q_LORA ** -0.5),
        "g_kv": gain(ks[13], (DEPTH, KV_LORA)),
        "w_ukv": nrm(ks[14], (DEPTH, KV_LORA, A_HEADS * (A_NOPE + A_V)), KV_LORA ** -0.5),
        "w_ao": nrm(ks[15], (DEPTH, A_HEADS * A_V, D_MODEL), (A_HEADS * A_V) ** -0.5),
        "w_out": nrm(ks[16], (DEPTH, D_MODEL, D_MODEL), D_MODEL ** -0.5),
        "g_ffn": gain(ks[17], (DEPTH, D_MODEL)),
        "w_gate": nrm(ks[18], (DEPTH, D_MODEL, D_FF), D_MODEL ** -0.5),
        "w_up": nrm(ks[19], (DEPTH, D_MODEL, D_FF), D_MODEL ** -0.5),
        "w_down": nrm(ks[20], (DEPTH, D_FF, D_MODEL), D_FF ** -0.5),
        "w_ple": nrm(ks[21], (DEPTH, PLE_DIM, D_MODEL), PLE_DIM ** -0.5),
        "w_ple_gate": nrm(ks[22], (DEPTH, D_MODEL, D_MODEL), D_MODEL ** -0.5),
        "g_final": gain(ks[23], (D_MODEL,)),
    }


def reference(x_prompt, x_sample, p_prompt, p_sample, g_mix, w_in, b_gate, conv_w, g_mhead, w_mo,
              g_q, w_uq, g_kv, w_ukv, w_ao, w_out, g_ffn, w_gate, w_up, w_down, w_ple, w_ple_gate,
              g_final):
    y_prompt = encoder(x_prompt, p_prompt, g_mix, w_in, b_gate, conv_w, g_mhead, w_mo, g_q, w_uq,
                       g_kv, w_ukv, w_ao, w_out, g_ffn, w_gate, w_up, w_down, w_ple, w_ple_gate, g_final)
    y_sample = encoder(x_sample, p_sample, g_mix, w_in, b_gate, conv_w, g_mhead, w_mo, g_q, w_uq,
                       g_kv, w_ukv, w_ao, w_out, g_ffn, w_gate, w_up, w_down, w_ple, w_ple_gate, g_final)
    return (y_prompt, y_sample)
```

```cpp
#include <hip/hip_runtime.h>
#include <cstdio>
#include <cstdint>
namespace pg8 {
#define PG8_LAS __attribute__((address_space(3)))
typedef unsigned short bf16_t;
typedef short bf16x8 __attribute__((ext_vector_type(8)));
typedef float f32x4 __attribute__((ext_vector_type(4)));
typedef unsigned u32x4 __attribute__((ext_vector_type(4)));
constexpr int BM = 256, BK = 64, HALF = 128, HTB = HALF * BK * 2  , STAGE_BYTES = 8 * HTB, NXCD = 8, WGM = 8;

__host__ __device__ __forceinline__ int lds_byte(int r, int c) { const int st = (r >> 4) * 2 + (c >> 5), rr = r & 15, cc = c & 31, ob = rr * 64 + cc * 2; return st * 1024 + (ob ^ (((ob >> 9) & 1) << 5)); }
__host__ __device__ __forceinline__ void stage_rc(int b, int& R, int& C) { const int st = b / 1024, sb = b % 1024, swz = sb ^ (((sb >> 9) & 1) << 5); R = (st >> 1) * 16 + swz / 64; C = (st & 1) * 32 + (swz % 64) / 2; }
__host__ __device__ __forceinline__ int perm32(int rho) { const int n = rho >> 4, i = rho & 15; return 8 * (i >> 2) + 4 * n + (i & 3); }

struct Unit { int pm, pn; };
struct Gemm { const bf16_t* A; const bf16_t* Bt; int M, N, K; };

struct StaticOrder {
    int nM, nN, nwg, G, c;
    __host__ __device__ void init(int M, int N, int G_, int c_) { nM = M / BM; nN = N / BM; nwg = nM * nN; G = G_; c = c_; }
    __host__ __device__ bool next(int i, Unit& u) const {
        const long L = (long)i * G + c; if (L >= nwg) return false;
        int wgid = (int)L; { const int q = nwg / NXCD, r = nwg % NXCD, xcd = wgid % NXCD, off = wgid / NXCD; wgid = (xcd < r ? xcd * (q + 1) : r * (q + 1) + (xcd - r) * q) + off; }
        const int nig = WGM * nN, gid = wgid / nig, fm = gid * WGM, gsz = (nM - fm) < WGM ? (nM - fm) : WGM;
        u.pm = fm + ((wgid % nig) % gsz); u.pn = (wgid % nig) / gsz; return true;
    }
    __device__ __forceinline__ void a_ready(const Unit&) const {}
    __device__ __forceinline__ void done(const Unit&) const {}
};
typedef float f32x2 __attribute__((ext_vector_type(2)));
typedef __bf16 bf16x2_t __attribute__((ext_vector_type(2)));
__device__ __forceinline__ unsigned cvt_pk_bf16(float lo, float hi) { f32x2 v = {lo, hi}; bf16x2_t b = __builtin_convertvector(v, bf16x2_t); return __builtin_bit_cast(unsigned, b); }
__device__ __forceinline__ u32x4 pk8(f32x4 a, f32x4 b) { u32x4 w; w.x = cvt_pk_bf16(a[0], a[1]); w.y = cvt_pk_bf16(a[2], a[3]); w.z = cvt_pk_bf16(b[0], b[1]); w.w = cvt_pk_bf16(b[2], b[3]); return w; }
template <class F> struct Epi8 {
    static constexpr bool PERM = true, AFTER_DRAIN = false;
    F f;
    __device__ __forceinline__ void operator()(const f32x4 (&acc)[2][2][4][2], const Unit& u, int wr, int wc, int fr, int fq) const {
        const int row0 = u.pm * BM + wr * 64 + fr, col0 = u.pn * BM + wc * 32 + 8 * fq;
#pragma unroll
        for (int ai = 0; ai < 2; ++ai)
#pragma unroll
            for (int m = 0; m < 4; ++m)
            {   f(row0 + ai * HALF + m * 16, col0, acc[ai][0][m][0], acc[ai][0][m][1], acc[ai][1][m][0], acc[ai][1][m][1], u.pn, wc, fq);
                asm volatile("" ::: "memory"); }
    }
};

template <class Epi, class Sched, bool ALIGN_EPI = false, bool SP2 = false>
__device__ __forceinline__ void gemm_phase(PG8_LAS unsigned char* lds, const Gemm g, const Sched& S, const Epi& E) {
    const int tid = threadIdx.x, wid = __builtin_amdgcn_readfirstlane(tid >> 6), lane = tid & 63, wr = wid >> 2, wc = wid & 3, fr = lane & 15, fq = lane >> 4;
    const int K = g.K, nt = K / BK;
    unsigned voffA[2], voffB[2];
#pragma unroll
    for (int i = 0; i < 2; ++i) { int R, C; stage_rc(tid * 16 + i * 8192, R, C); const int Rb = Epi::PERM ? ((R & ~31) + perm32(R & 31)) : R;
        voffA[i] = (unsigned)(R * K + C) * 2u; voffB[i] = (unsigned)(Rb * K + C) * 2u; }
    const size_t kstep = (size_t)(BK * 2);
    const size_t hstep = (size_t)HALF * K * 2;
    const size_t tstep = 2 * hstep;
    const unsigned ldsw = (unsigned)wid * 1024u;
    const int aoff = lds_byte(wr * 64 + fr, fq * 8), boff = lds_byte(wc * 32 + fr, fq * 8);
#define PG8_SA(b, h) (((b) * 2 + (h)) * HTB)
#define PG8_SB(b, h) ((4 + (b) * 2 + (h)) * HTB)
#define PG8_STAGE(bufoff, gbase, voff) do { _Pragma("unroll") for (int _i = 0; _i < 2; ++_i) \
        __builtin_amdgcn_global_load_lds((const unsigned*)((const char*)(gbase) + (voff)[_i]), (PG8_LAS unsigned*)(lds + (bufoff) + ldsw + _i * 8192), 16, 0, 0); } while (0)
#define PG8_LDA(dst, b, h) do { _Pragma("unroll") for (int m = 0; m < 4; ++m) _Pragma("unroll") for (int k = 0; k < 2; ++k) dst[m][k] = *(const PG8_LAS bf16x8*)(lds + PG8_SA(b, h) + aoff + m * 2048 + k * 1024); } while (0)
#define PG8_LDB(dst, b, h) do { _Pragma("unroll") for (int n = 0; n < 2; ++n) _Pragma("unroll") for (int k = 0; k < 2; ++k) dst[n][k] = *(const PG8_LAS bf16x8*)(lds + PG8_SB(b, h) + boff + n * 2048 + k * 1024); } while (0)
#define PG8_MMA(ai, bj, At, Bt) do { __builtin_amdgcn_s_setprio(1); _Pragma("unroll") for (int m = 0; m < 4; ++m) _Pragma("unroll") for (int n = 0; n < 2; ++n) _Pragma("unroll") for (int k = 0; k < 2; ++k) \
        acc[ai][bj][m][n] = __builtin_amdgcn_mfma_f32_16x16x32_bf16(Bt[n][k], At[m][k], acc[ai][bj][m][n], 0, 0, 0); __builtin_amdgcn_s_setprio(0); } while (0)
#define PG8_WAIT_V(n) asm volatile("s_waitcnt vmcnt(" #n ")" ::: "memory")
#define PG8_WAIT_L(n) asm volatile("s_waitcnt lgkmcnt(" #n ")" ::: "memory")
#define PG8_BAR __builtin_amdgcn_s_barrier()
#define PG8_SCHED __builtin_amdgcn_sched_barrier(0)
    Unit cur, nxt; int ui = 0;
    if (!S.next(0, cur)) return;
    f32x4 acc[2][2][4][2];
#pragma unroll
    for (int a = 0; a < 2; ++a)
#pragma unroll
        for (int b = 0; b < 2; ++b)
#pragma unroll
            for (int m = 0; m < 4; ++m)
#pragma unroll
                for (int n = 0; n < 2; ++n) acc[a][b][m][n] = (f32x4){0.f, 0.f, 0.f, 0.f};
    bf16x8 At[4][2], B0[2][2], B1[2][2];
    const char* cA = (const char*)g.A + (size_t)cur.pm * tstep; const char* cB = (const char*)g.Bt + (size_t)cur.pn * tstep;
    S.a_ready(cur);
    if constexpr (SP2) {
        PG8_STAGE(PG8_SB(0, 0), cB, voffB); PG8_STAGE(PG8_SB(0, 1), cB + hstep, voffB); PG8_STAGE(PG8_SA(0, 0), cA, voffA); PG8_STAGE(PG8_SA(0, 1), cA + hstep, voffA);
        if (wr == 1) PG8_BAR;
        PG8_WAIT_V(2); PG8_BAR;
        PG8_STAGE(PG8_SB(1, 0), cB + kstep, voffB); PG8_STAGE(PG8_SA(1, 0), cA + kstep, voffA); PG8_STAGE(PG8_SB(1, 1), cB + hstep + kstep, voffB);
        PG8_WAIT_V(6); PG8_BAR;
    } else {
        PG8_STAGE(PG8_SB(0, 0), cB, voffB); PG8_STAGE(PG8_SA(0, 0), cA, voffA); PG8_STAGE(PG8_SB(0, 1), cB + hstep, voffB); PG8_STAGE(PG8_SA(0, 1), cA + hstep, voffA);
        if (wr == 1) PG8_BAR;
        PG8_WAIT_V(4); PG8_BAR;
        PG8_STAGE(PG8_SB(1, 0), cB + kstep, voffB); PG8_STAGE(PG8_SA(1, 0), cA + kstep, voffA); PG8_STAGE(PG8_SB(1, 1), cB + hstep + kstep, voffB);
        PG8_WAIT_V(6); PG8_BAR;
    }
    for (;;) {
        const bool has_next = S.next(ui + 1, nxt);
        const char* nA = has_next ? (const char*)g.A + (size_t)nxt.pm * tstep : cA; const char* nB = has_next ? (const char*)g.Bt + (size_t)nxt.pn * tstep : cB;
        for (int t = 0; t < nt; t += 2) {
            const bool last = (t == nt - 2);
            const char* a1 = cA + (size_t)(t + 1) * kstep;
            const char* a2 = last ? nA : cA + (size_t)(t + 2) * kstep; const char* b2 = last ? nB : cB + (size_t)(t + 2) * kstep;
            const char* a3 = a2 + kstep; const char* b3 = b2 + kstep;
            if (last && has_next) S.a_ready(nxt);
            if constexpr (SP2) {
            PG8_LDB(B0, 0, 0); PG8_LDB(B1, 0, 1); PG8_SCHED; PG8_LDA(At, 0, 0); PG8_STAGE(PG8_SA(1, 1), a1 + hstep, voffA);
            PG8_WAIT_V(8); PG8_WAIT_L(0); PG8_BAR; PG8_MMA(0, 0, At, B0); PG8_MMA(0, 1, At, B1); PG8_BAR; PG8_SCHED;
            PG8_LDA(At, 0, 1); PG8_STAGE(PG8_SB(0, 0), b2, voffB); PG8_STAGE(PG8_SB(0, 1), b2 + hstep, voffB); PG8_STAGE(PG8_SA(0, 0), a2, voffA);
            PG8_WAIT_V(8); PG8_WAIT_L(0); PG8_BAR; PG8_MMA(1, 0, At, B0); PG8_MMA(1, 1, At, B1); PG8_BAR; PG8_SCHED;
            PG8_LDB(B0, 1, 0); PG8_LDB(B1, 1, 1); PG8_SCHED; PG8_LDA(At, 1, 0); PG8_STAGE(PG8_SA(0, 1), a2 + hstep, voffA);
            PG8_WAIT_V(8); PG8_WAIT_L(0); PG8_BAR; PG8_MMA(0, 0, At, B0); PG8_MMA(0, 1, At, B1); PG8_BAR; PG8_SCHED;
            PG8_LDA(At, 1, 1); PG8_STAGE(PG8_SB(1, 0), b3, voffB); PG8_STAGE(PG8_SB(1, 1), b3 + hstep, voffB); PG8_STAGE(PG8_SA(1, 0), a3, voffA);
            PG8_WAIT_V(8); PG8_WAIT_L(0); PG8_BAR; PG8_MMA(1, 0, At, B0); PG8_MMA(1, 1, At, B1); PG8_BAR; PG8_SCHED;
            } else {
            PG8_LDB(B0, 0, 0); PG8_SCHED; PG8_LDA(At, 0, 0); PG8_STAGE(PG8_SA(1, 1), a1 + hstep, voffA);
            PG8_WAIT_L(8); PG8_BAR; PG8_WAIT_L(0); PG8_MMA(0, 0, At, B0); PG8_BAR; PG8_SCHED;
            PG8_LDB(B1, 0, 1); PG8_STAGE(PG8_SB(0, 0), b2, voffB);
            PG8_BAR; PG8_WAIT_L(0); PG8_MMA(0, 1, At, B1); PG8_BAR;
            PG8_LDA(At, 0, 1); PG8_STAGE(PG8_SA(0, 0), a2, voffA);
            PG8_BAR; PG8_WAIT_L(0); PG8_MMA(1, 0, At, B0); PG8_BAR; PG8_SCHED;
            PG8_STAGE(PG8_SB(0, 1), b2 + hstep, voffB);
            PG8_WAIT_V(6); PG8_BAR; PG8_MMA(1, 1, At, B1); PG8_BAR;
            PG8_LDB(B0, 1, 0); PG8_SCHED; PG8_LDA(At, 1, 0); PG8_STAGE(PG8_SA(0, 1), a2 + hstep, voffA);
            PG8_WAIT_L(8); PG8_BAR; PG8_WAIT_L(0); PG8_MMA(0, 0, At, B0); PG8_BAR; PG8_SCHED;
            PG8_LDB(B1, 1, 1); PG8_STAGE(PG8_SB(1, 0), b3, voffB);
            PG8_BAR; PG8_WAIT_L(0); PG8_MMA(0, 1, At, B1); PG8_BAR;
            PG8_LDA(At, 1, 1); PG8_STAGE(PG8_SA(1, 0), a3, voffA);
            PG8_BAR; PG8_WAIT_L(0); PG8_MMA(1, 0, At, B0); PG8_BAR; PG8_SCHED;
            PG8_STAGE(PG8_SB(1, 1), b3 + hstep, voffB);
            PG8_WAIT_V(6); PG8_BAR; PG8_MMA(1, 1, At, B1); PG8_BAR;
            }
        }
        if constexpr (ALIGN_EPI) { if (wr == 0) PG8_BAR; }
        if constexpr (!Epi::AFTER_DRAIN) { E(acc, cur, wr, wc, fr, fq); S.done(cur); }
        if (!has_next) break;
#pragma unroll
        for (int a = 0; a < 2; ++a)
#pragma unroll
            for (int b = 0; b < 2; ++b)
#pragma unroll
                for (int m = 0; m < 4; ++m)
#pragma unroll
                    for (int n = 0; n < 2; ++n) acc[a][b][m][n] = (f32x4){0.f, 0.f, 0.f, 0.f};
        cur = nxt; cA = nA; cB = nB; ++ui;
        if constexpr (ALIGN_EPI) { if (wr == 1) PG8_BAR; }
    }
    PG8_WAIT_V(0);
    if constexpr (!ALIGN_EPI) { if (wr == 0) PG8_BAR; }
    PG8_BAR;
    if constexpr (Epi::AFTER_DRAIN) { E.fused(acc, cur, wr, wc, fr, fq, lds, wid, lane); S.done(cur); }
#undef PG8_SA
#undef PG8_SB
#undef PG8_STAGE
#undef PG8_LDA
#undef PG8_LDB
#undef PG8_MMA
#undef PG8_WAIT_V
#undef PG8_WAIT_L
#undef PG8_BAR
#undef PG8_SCHED
}
}
#define GAS __attribute__((address_space(1)))
#define LAS __attribute__((address_space(3)))
typedef unsigned short bf16;
typedef unsigned v4u __attribute__((ext_vector_type(4)));
typedef float f32x4 __attribute__((ext_vector_type(4)));
typedef short bf16x8 __attribute__((ext_vector_type(8)));
typedef GAS unsigned gu32;
typedef GAS unsigned long long gu64;
#define RLX_AGENT __ATOMIC_RELAXED, __HIP_MEMORY_SCOPE_AGENT
#define LDS_WAIT() asm volatile("s_waitcnt lgkmcnt(0)" ::: "memory")
#define VM_WAIT() asm volatile("s_waitcnt vmcnt(0)" ::: "memory")
__device__ __forceinline__ unsigned long long rt() { return __builtin_amdgcn_s_memrealtime(); }
__device__ __forceinline__ unsigned f2bf(float f) { unsigned u = __builtin_bit_cast(unsigned, f); return (u + 0x7fffu + ((u >> 16) & 1u)) >> 16; }
__device__ __forceinline__ unsigned pk2(float lo, float hi) { return f2bf(lo) | (f2bf(hi) << 16); }

#define XB_TMO      128
#define XB_XCNT(j)  (256  + 64 * (j))
#define XB_XSUB(j)  (1280 + 64 * (j))
#define XB_XGEN(j)  (2304 + 64 * (j))
#define XB_TOP      3328
#define XB_TOPGEN   3392
#define XCD_BAR_WORDS 3456
#define XB_SPIN_CAP (1u << 18)

__device__ __forceinline__ unsigned xb_ld(unsigned* p)              { return __hip_atomic_load(p, __ATOMIC_RELAXED, __HIP_MEMORY_SCOPE_AGENT); }
__device__ __forceinline__ unsigned xb_add(unsigned* p, unsigned v) { return __hip_atomic_fetch_add(p, v, __ATOMIC_RELAXED, __HIP_MEMORY_SCOPE_AGENT); }
__device__ __forceinline__ unsigned xb_xcc_id() { return (unsigned)__builtin_amdgcn_s_getreg((3 << 11) | 20) & 0xFu; }
#define XB_SPIN(cond, bar) do { unsigned _sp = 0; while (cond) { __builtin_amdgcn_s_sleep(1); \
    if ((++_sp & 255u) == 0u) { if (xb_ld(&(bar)[XB_TMO])) break; if (_sp > XB_SPIN_CAP) { atomicAdd(&(bar)[XB_TMO], 1u); break; } } } } while (0)

struct XcdBarrier {
    unsigned* bar; unsigned x;
    volatile LAS unsigned* st;
};

__device__ __forceinline__ XcdBarrier xcd_barrier_post(unsigned* bar, volatile LAS unsigned* st) {
    XcdBarrier b; b.bar = bar; b.x = xb_xcc_id(); b.st = st;
    if (threadIdx.x == 0) (void)xb_add(&bar[XB_XCNT(b.x)], 1u);
    return b;
}
__device__ __forceinline__ void xcd_barrier_complete(unsigned* bar, unsigned x, unsigned& nloc, unsigned& nx) {
    const unsigned G = gridDim.x * gridDim.y * gridDim.z;
    unsigned sum, cnt, mine, sp = 0u;
    for (;;) {
        sum = 0u; cnt = 0u; mine = 0u;
#pragma unroll
        for (unsigned j = 0; j < 16; ++j) { const unsigned c = xb_ld(&bar[XB_XCNT(j)]); sum += c; cnt += (c > 0u) ? 1u : 0u; mine = (j == x) ? c : mine; }
        if (sum == G) break;
        __builtin_amdgcn_s_sleep(1);
        if ((++sp & 255u) == 0u) { if (xb_ld(&bar[XB_TMO])) break; if (sp > XB_SPIN_CAP) { atomicAdd(&bar[XB_TMO], 1u); break; } }
    }
    nloc = mine > 0u ? mine : 1u; nx = cnt > 0u ? cnt : 1u;
}

__device__ __forceinline__ void xcd_barrier(const XcdBarrier& b) {
    asm volatile("s_waitcnt vmcnt(0)" ::: "memory");
    __syncthreads();
    if (threadIdx.x == 0) {
        unsigned* bar = b.bar;
        __builtin_amdgcn_s_waitcnt(0);
        unsigned nloc = b.st[0], nx = b.st[1];
        if (nloc == 0u) { xcd_barrier_complete(bar, b.x, nloc, nx); b.st[0] = nloc; b.st[1] = nx; }
        const unsigned old = xb_add(&bar[XB_XSUB(b.x)], 1u);
        const unsigned gen = old / nloc;
        if (old + 1u == (gen + 1u) * nloc) {
            __builtin_amdgcn_fence(__ATOMIC_RELEASE, "agent");
            asm volatile("s_waitcnt vmcnt(0)" ::: "memory");
            const unsigned og = xb_add(&bar[XB_TOP], 1u);
            const unsigned tg = og / nx;
            if (og + 1u == (tg + 1u) * nx) xb_add(&bar[XB_TOPGEN], 1u);
            else XB_SPIN(xb_ld(&bar[XB_TOPGEN]) == tg, bar);
            __builtin_amdgcn_fence(__ATOMIC_ACQUIRE, "agent");
            xb_add(&bar[XB_XGEN(b.x)], 1u);
            asm volatile("s_waitcnt vmcnt(0)" ::: "memory");
        } else {
            XB_SPIN(xb_ld(&bar[XB_XGEN(b.x)]) == gen, bar);
            __builtin_amdgcn_fence(__ATOMIC_ACQUIRE, "agent");
            asm volatile("s_waitcnt vmcnt(0)" ::: "memory");
        }
    }
    __syncthreads();
}

constexpr int DM = 1024, SEQ = 4096, NSEQ = 20, MP = 16 * 4096, M = NSEQ * SEQ;
constexpr int DFF = 2816, NIN = 5888, NGU = 5632;
constexpr float EPS = 1e-6f;
constexpr float L2E = 1.4426950408889634f;
constexpr int NWAVES = 8;

constexpr size_t MiB = 1u << 20;
constexpr size_t WS_CTL = 0, CTL_ZERO_BYTES = 1 * MiB;
constexpr size_t WS_TAB = 1 * MiB;
constexpr size_t WS_WIN = 2 * MiB, WS_WMO = 14 * MiB, WS_WUQ = 16 * MiB, WS_WUKV = 17 * MiB, WS_WAO = 18 * MiB, WS_WOUT = 20 * MiB,
                 WS_WGU = 22 * MiB, WS_WDN = 33 * MiB, WS_WPLE = 39 * MiB, WS_WPG = 40 * MiB;
constexpr size_t WS_R1 = 64 * MiB, WS_R2 = 224 * MiB, WS_R3 = 384 * MiB, WS_R4 = 544 * MiB, WS_R5 = 704 * MiB;
constexpr size_t WS_CQ = 864 * MiB, WS_CKV = 904 * MiB, WS_KR = 944 * MiB, WS_G = 954 * MiB, WS_SSQQ = 959 * MiB, WS_SSQKV = 961 * MiB,
                 WS_SSQ1 = 963 * MiB, WS_PB = 968 * MiB, WS_END = 1024 * MiB;
static_assert(WS_WIN + (size_t)NIN * 1024 * 2 <= WS_WMO && WS_WGU + (size_t)NGU * 1024 * 2 <= WS_WDN && WS_WDN + (size_t)1024 * DFF * 2 <= WS_WPLE && WS_WPG + 2 * MiB <= WS_R1, "weight map");
static_assert(WS_R1 + (size_t)M * 1024 * 2 == WS_R2 && WS_R5 + (size_t)M * 1024 * 2 == WS_CQ && WS_PB + (size_t)M * 256 * 2 <= WS_END, "activation map");
static_assert(WS_CQ + (size_t)M * 256 * 2 <= WS_CKV && WS_KR + (size_t)M * 64 * 2 <= WS_G && WS_G + (size_t)M * 16 * 4 <= WS_SSQQ && WS_SSQQ + (size_t)M * 16 <= WS_SSQKV && WS_SSQ1 + (size_t)M * 64 <= WS_PB, "small map");
constexpr int CW_BAR = 4096;
constexpr int RING_BYTES = 131072, PHASE_LDS = 155648, MISC_OFF = PHASE_LDS + 320, LDS_BYTES = 159744;

typedef float f32x16 __attribute__((ext_vector_type(16)));
typedef short s16x4 __attribute__((ext_vector_type(4)));
typedef float f32x2g __attribute__((ext_vector_type(2)));

__device__ __forceinline__ unsigned cvtpk(float lo, float hi) { return pg8::cvt_pk_bf16(lo, hi); }
__device__ __forceinline__ float bflo(unsigned w) { return __uint_as_float(w << 16); }
__device__ __forceinline__ float bfhi(unsigned w) { return __uint_as_float(w & 0xffff0000u); }
__device__ __forceinline__ float fexp(float x) { return __builtin_amdgcn_exp2f(x * L2E); }
__device__ __forceinline__ float fsigmoid(float x) { return __builtin_amdgcn_rcpf(1.f + __builtin_amdgcn_exp2f(-x * L2E)); }
__device__ __forceinline__ f32x4 sig4(f32x4 v) { return (f32x4){fsigmoid(v[0]), fsigmoid(v[1]), fsigmoid(v[2]), fsigmoid(v[3])}; }
__device__ __forceinline__ v4u pk8g(f32x4 a, f32x4 b) { v4u w; w.x = cvtpk(a[0], a[1]); w.y = cvtpk(a[2], a[3]); w.z = cvtpk(b[0], b[1]); w.w = cvtpk(b[2], b[3]); return w; }
__device__ __forceinline__ void unpk8(v4u w, f32x4& a, f32x4& b) { a = (f32x4){bflo(w.x), bfhi(w.x), bflo(w.y), bfhi(w.y)}; b = (f32x4){bflo(w.z), bfhi(w.z), bflo(w.w), bfhi(w.w)}; }
__device__ __forceinline__ float wave_sum(float v) {
#pragma unroll
    for (int o = 1; o < 64; o <<= 1) v += __shfl_xor(v, o);
    return v;
}
__device__ __forceinline__ int lane_id() { return (int)__builtin_amdgcn_mbcnt_hi(~0u, __builtin_amdgcn_mbcnt_lo(~0u, 0u)); }
__device__ __forceinline__ int sig16(int n) { return (n & ~12) | ((n & 4) << 1) | ((n & 8) >> 1); }

struct WDesc { const float* W; const float* gain; bf16* WT; int K, Nsrc, mat; };
__device__ __forceinline__ int src_col(int mat, int n) {
    if (mat == 0) {
        if (n < 1024) return sig16(n);
        if (n < 3072) return n;
        if (n < 5120) return 3664 + (n - 3072);
        if (n < 5376) return 3088 + (n - 5120);
        if (n < 5632) return 3344 + (n - 5376);
        const int j = n - 5632; if (j < 64) return 3600 + (j >> 1) + 32 * (j & 1); if (j < 80) return 3072 + (j - 64); return -1;
    }
    if (mat == 2) {
        if (n < 1024) return (n >> 7) * 192 + (n & 127);
        const int mm = n - 1024, hh = mm >> 6, j = mm & 63; return hh * 192 + 128 + (j >> 1) + 32 * (j & 1);
    }
    if (mat == 3) {
        if (n < 1024) return (n >> 7) * 256 + (n & 127);
        const int mm = n - 1024; return (mm >> 7) * 256 + 128 + (mm & 127);
    }
    return n;
}
__device__ __forceinline__ void wt_item(const float* W, const float* gain, bf16* WT, int K, int Nsrc, int Ndst, int mat, const float* Wup, LAS float* scr, int item, int lane) {
    const int nblk = Ndst / 32, kb = item / nblk, nb = item % nblk, k0 = 64 * kb, n0 = 32 * nb;
    int sc; const float* Ws = W;
    if (mat == 6) { const int pn = n0 >> 8, r0 = n0 & 255; if (r0 >= 128) Ws = Wup; sc = 128 * pn + (r0 & 127) + (lane & 31); }
    else sc = src_col(mat, n0 + (lane & 31));
#pragma unroll 8
    for (int i = 0; i < 32; ++i) { const int kk = 2 * i + (lane >> 5); float v = 0.f; if (sc >= 0) v = Ws[(size_t)(k0 + kk) * Nsrc + sc]; if (gain) v *= gain[k0 + kk]; scr[kk * 33 + (lane & 31)] = v; }
    LDS_WAIT(); asm volatile("" ::: "memory");
    const int c = lane & 7;
#pragma unroll
    for (int j = 0; j < 4; ++j) { const int n = (lane >> 3) + 8 * j; const LAS float* s = scr + (8 * c) * 33 + n;
        v4u o; o.x = cvtpk(s[0 * 33], s[1 * 33]); o.y = cvtpk(s[2 * 33], s[3 * 33]); o.z = cvtpk(s[4 * 33], s[5 * 33]); o.w = cvtpk(s[6 * 33], s[7 * 33]);
        *(GAS v4u*)(WT + (size_t)(n0 + n) * K + k0 + 8 * c) = o; }
    LDS_WAIT(); asm volatile("" ::: "memory");
}
__device__ __forceinline__ void sincos_d(double r, double& s, double& c) {
    const double r2 = r * r; double ts = 1.0, tc = 1.0, ss = 1.0, cc = 1.0;
#pragma unroll
    for (int k = 1; k <= 13; ++k) { tc *= -r2 / (double)((2 * k - 1) * (2 * k)); ts *= -r2 / (double)((2 * k) * (2 * k + 1)); cc += tc; ss += ts; }
    s = ss * r; c = cc;
}
__device__ __forceinline__ const float* in_ptr(int k);
__device__ __forceinline__ void p0_prologue(unsigned char* ws, LAS unsigned char* lds, int vcu, int G, int wave, int lane, int tid) {
    LAS float* scr = (LAS float*)(lds + wave * 16384);
    const int gw = vcu * NWAVES + wave, NGW = G * NWAVES;
    constexpr int I_IN = 16 * (NIN / 32), I_SQ = 16 * 32, I_UQ = 4 * 48, I_UKV = 4 * 64, I_GU = 16 * (NGU / 32), I_DN = 44 * 32, I_PLE = 4 * 32;
    constexpr int NITEMS = I_IN + I_SQ + I_UQ + I_UKV + I_SQ + I_SQ + I_GU + I_DN + I_PLE + I_SQ;
    for (int it = gw; it < NITEMS; it += NGW) {
        int r = it;
        if (r < I_IN)  { wt_item(in_ptr(5), nullptr, (bf16*)(ws + WS_WIN), 1024, 5712, NIN, 0, nullptr, scr, r, lane); continue; } r -= I_IN;
        if (r < I_SQ)  { wt_item(in_ptr(9), nullptr, (bf16*)(ws + WS_WMO), 1024, 1024, 1024, 1, nullptr, scr, r, lane); continue; } r -= I_SQ;
        if (r < I_UQ)  { wt_item(in_ptr(11), in_ptr(10), (bf16*)(ws + WS_WUQ), 256, 1536, 1536, 2, nullptr, scr, r, lane); continue; } r -= I_UQ;
        if (r < I_UKV) { wt_item(in_ptr(13), in_ptr(12), (bf16*)(ws + WS_WUKV), 256, 2048, 2048, 3, nullptr, scr, r, lane); continue; } r -= I_UKV;
        if (r < I_SQ)  { wt_item(in_ptr(14), nullptr, (bf16*)(ws + WS_WAO), 1024, 1024, 1024, 1, nullptr, scr, r, lane); continue; } r -= I_SQ;
        if (r < I_SQ)  { wt_item(in_ptr(15), nullptr, (bf16*)(ws + WS_WOUT), 1024, 1024, 1024, 1, nullptr, scr, r, lane); continue; } r -= I_SQ;
        if (r < I_GU)  { wt_item(in_ptr(17), in_ptr(16), (bf16*)(ws + WS_WGU), 1024, DFF, NGU, 6, in_ptr(18), scr, r, lane); continue; } r -= I_GU;
        if (r < I_DN)  { wt_item(in_ptr(19), nullptr, (bf16*)(ws + WS_WDN), DFF, 1024, 1024, 1, nullptr, scr, r, lane); continue; } r -= I_DN;
        if (r < I_PLE) { wt_item(in_ptr(20), nullptr, (bf16*)(ws + WS_WPLE), 256, 1024, 1024, 1, nullptr, scr, r, lane); continue; } r -= I_PLE;
        wt_item(in_ptr(21), nullptr, (bf16*)(ws + WS_WPG), 1024, 1024, 1024, 1, nullptr, scr, r, lane);
    }
    {
        const GAS f32x4* gm = (const GAS f32x4*)in_ptr(4) + lane; f32x4 gv[4];
#pragma unroll
        for (int j = 0; j < 4; ++j) gv[j] = gm[64 * j];
        bf16* H = (bf16*)(ws + WS_R1);
        for (int m = gw; m < M; m += NGW) {
            const float* xrow = (m < MP) ? in_ptr(0) + (size_t)m * DM : in_ptr(1) + (size_t)(m - MP) * DM;
            const GAS f32x4* xr = (const GAS f32x4*)xrow + lane; f32x4 v[4]; float s = 0.f;
#pragma unroll
            for (int j = 0; j < 4; ++j) { v[j] = xr[64 * j]; s += (v[j].x * v[j].x + v[j].y * v[j].y) + (v[j].z * v[j].z + v[j].w * v[j].w); }
            const float rstd = 1.0f / sqrtf(wave_sum(s) * (1.f / DM) + EPS);
            GAS unsigned long long* o8 = (GAS unsigned long long*)(H + (size_t)m * DM) + lane;
#pragma unroll
            for (int j = 0; j < 4; ++j) o8[64 * j] = (unsigned long long)cvtpk(v[j].x * rstd * gv[j].x, v[j].y * rstd * gv[j].y) | ((unsigned long long)cvtpk(v[j].z * rstd * gv[j].z, v[j].w * rstd * gv[j].w) << 32);
        }
    }
    {
        bf16* PB = (bf16*)(ws + WS_PB); const long n8 = (long)M * 256 / 8, np8 = (long)MP * 256 / 8;
        for (long i = (long)gw * 64 + lane; i < n8; i += (long)NGW * 64) {
            const float* src = (i < np8) ? in_ptr(2) + i * 8 : in_ptr(3) + (i - np8) * 8;
            const f32x4 a = *(const GAS f32x4*)src, b = *(const GAS f32x4*)(src + 4);
            *(GAS v4u*)(PB + i * 8) = pk8g(a, b);
        }
    }
    {
        f32x2g* tab = (f32x2g*)(ws + WS_TAB);
        for (int e = gw * 64 + lane; e < SEQ * 32; e += NGW * 64) {
            const int pos = e >> 5, i = e & 31;
            const double invf = exp(-(double)i * (9.210340371976184 / 32.0));
            const double ang = (double)pos * invf;
            const double k = rint(ang * 0.15915494309189535);
            const double r = ang - k * 6.283185307179586;
            double s, c; sincos_d(r, s, c);
            tab[e] = (f32x2g){(float)c, (float)s};
        }
    }
}

__device__ __forceinline__ void t1_conv(const bf16* QKraw, bf16* QKc, const float* conv_w, int gw, int NGW, int lane) {
    constexpr int NITEM = (M / 32) * 2;
    for (int it = gw; it < NITEM; it += NGW) {
        const int half = it & 1, rb = it >> 1, row0 = rb * 32, t0 = row0 & (SEQ - 1), c0 = half * 512 + lane * 8;
        float w[5][8];
#pragma unroll
        for (int j = 0; j < 5; ++j)
#pragma unroll
            for (int k = 0; k < 8; ++k) w[j][k] = conv_w[j * 1024 + sig16(c0 + k)];
        const float osc = (half == 0) ? 0.08838834764831845f : 1.0f;
        const bf16* base = QKraw + (size_t)row0 * 1024 + c0;
        f32x4 xa[5], xb[5];
#pragma unroll
        for (int j = 0; j < 5; ++j) { xa[j] = (f32x4){0.f, 0.f, 0.f, 0.f}; xb[j] = xa[j]; }
#pragma unroll
        for (int j = 0; j < 4; ++j) { const int t = t0 + j - 2; if (t >= 0) { const v4u r = *(const GAS v4u*)(base + (long)(j - 2) * 1024); unpk8(r, xa[j + 1], xb[j + 1]); } }
        for (int i = 0; i < 32; ++i) {
#pragma unroll
            for (int j = 0; j < 4; ++j) { xa[j] = xa[j + 1]; xb[j] = xb[j + 1]; }
            const int t = t0 + i + 2;
            if (t < SEQ) { const v4u r = *(const GAS v4u*)(base + (long)(i + 2) * 1024); unpk8(r, xa[4], xb[4]); } else { xa[4] = (f32x4){0.f, 0.f, 0.f, 0.f}; xb[4] = xa[4]; }
            f32x4 oa = (f32x4){0.f, 0.f, 0.f, 0.f}, ob = oa;
#pragma unroll
            for (int j = 0; j < 5; ++j)
#pragma unroll
                for (int k = 0; k < 4; ++k) { oa[k] += xa[j][k] * w[j][k]; ob[k] += xb[j][k] * w[j][4 + k]; }
#pragma unroll
            for (int k = 0; k < 4; ++k) { oa[k] = oa[k] * fsigmoid(oa[k]) * osc; ob[k] = ob[k] * fsigmoid(ob[k]) * osc; }
            *(GAS v4u*)(QKc + (size_t)(row0 + i) * 1024 + c0) = pk8g(oa, ob);
        }
    }
}

__device__ __forceinline__ void t2_combine(const bf16* HMf, const bf16* HMb, bf16* OA, const float* g_mhead, int gw, int NGW, int lane) {
    f32x4 ga[2], gb[2];
#pragma unroll
    for (int i = 0; i < 2; ++i) { ga[i] = *(const GAS f32x4*)(g_mhead + 512 * i + 8 * lane); gb[i] = *(const GAS f32x4*)(g_mhead + 512 * i + 8 * lane + 4); }
    for (int m = gw; m < M; m += NGW) {
#pragma unroll
        for (int i = 0; i < 2; ++i) {
            const size_t off = (size_t)m * 1024 + 512 * i + 8 * lane;
            f32x4 fa, fb, ba, bb, oa, ob;
            unpk8(*(const GAS v4u*)(HMf + off), fa, fb); unpk8(*(const GAS v4u*)(HMb + off), ba, bb); unpk8(*(const GAS v4u*)(OA + off), oa, ob);
            fa += ba; fb += bb;
            float s = (fa[0] * fa[0] + fa[1] * fa[1]) + (fa[2] * fa[2] + fa[3] * fa[3]) + (fb[0] * fb[0] + fb[1] * fb[1]) + (fb[2] * fb[2] + fb[3] * fb[3]);
#pragma unroll
            for (int o = 1; o < 32; o <<= 1) s += __shfl_xor(s, o);
            const float rstd = 1.0f / sqrtf(s * (1.f / 256.f) + EPS);
            fa = fa * rstd * ga[i] * oa; fb = fb * rstd * gb[i] * ob;
            *(GAS v4u*)(OA + off) = pk8g(fa, fb);
        }
    }
}

__device__ __forceinline__ void t4_final(float* out, const float* g_final, int gw, int NGW, int lane) {
    f32x4 gv[4];
#pragma unroll
    for (int j = 0; j < 4; ++j) gv[j] = ((const GAS f32x4*)g_final + lane)[64 * j];
    for (int m = gw; m < M; m += NGW) {
        GAS f32x4* xr = (GAS f32x4*)(out + (size_t)m * DM) + lane; f32x4 v[4]; float s = 0.f;
#pragma unroll
        for (int j = 0; j < 4; ++j) { v[j] = xr[64 * j]; s += (v[j].x * v[j].x + v[j].y * v[j].y) + (v[j].z * v[j].z + v[j].w * v[j].w); }
        const float rstd = 1.0f / sqrtf(wave_sum(s) * (1.f / DM) + EPS);
#pragma unroll
        for (int j = 0; j < 4; ++j) xr[64 * j] = v[j] * rstd * gv[j];
    }
}

#define KSWZ(row, colB) ((row) * 256 + ((colB) ^ (((row) & 7) << 4)))
#define KRSWZ(row, colB) ((row) * 128 + ((colB) ^ ((((row) >> 1) & 7) << 4)))
#define SBAR() __builtin_amdgcn_sched_barrier(0)
__device__ __forceinline__ int crow(int r, int hi) { return (r & 3) + 8 * (r >> 2) + 4 * hi; }
__device__ __forceinline__ int v_st(int k, int c) { const int kk = (k & ~0xC) | ((k & 4) << 1) | ((k & 8) >> 1); return ((kk >> 3) * 4 + (c >> 5)) * 512 + ((kk & 7) * 32 + (c & 31)) * 2; }
__device__ __forceinline__ int v_rd_base(int lane) { return ((lane & 3) << 3) | (((lane >> 2) & 3) << 6) | (((lane >> 4) & 1) << 5) | (((lane >> 5) & 1) << 8); }
constexpr int v_rd_off(int d0, int ks, int half) { return d0 * 512 + ks * 4096 + half * 2048; }
template <int OFF> __device__ __forceinline__ s16x4 tr_read(int vb) {
    s16x4 r; asm volatile("ds_read_b64_tr_b16 %0, %1 offset:%2" : "=&v"(r) : "v"(vb), "i"(OFF) : "memory"); return r;
}
#define PKF(L, H) (bf16x8){L[0], L[1], L[2], L[3], H[0], H[1], H[2], H[3]}
#define PK4(P, BASE, OUT) do { unsigned a0_ = cvtpk(P[BASE + 0], P[BASE + 1]), a1_ = cvtpk(P[BASE + 2], P[BASE + 3]);   \
    unsigned b0_ = cvtpk(P[BASE + 4], P[BASE + 5]), b1_ = cvtpk(P[BASE + 6], P[BASE + 7]);                              \
    auto r0_ = __builtin_amdgcn_permlane32_swap(a0_, b0_, false, false); auto r1_ = __builtin_amdgcn_permlane32_swap(a1_, b1_, false, false); \
    v4u w_ = {r0_[0], r1_[0], r0_[1], r1_[1]}; OUT = __builtin_bit_cast(bf16x8, w_); } while (0)
__device__ __forceinline__ float swap_add(float x) { auto rr = __builtin_amdgcn_permlane32_swap(__float_as_uint(x), __float_as_uint(x), false, false); return __uint_as_float(rr[0]) + __uint_as_float(rr[1]); }
__device__ __forceinline__ float swap_max(float x) { auto rr = __builtin_amdgcn_permlane32_swap(__float_as_uint(x), __float_as_uint(x), false, false); return fmaxf(__uint_as_float(rr[0]), __uint_as_float(rr[1])); }

namespace att {
constexpr int NW = 8, QBLK = 32, KVBLK = 64;
constexpr float SCALE = 0.07216878364870322f;
constexpr float THR = 8.f;
constexpr int SHM_V = 16384, SHM_K = 16384, SHM_KR = 8192;
constexpr int OFF_V = 0, OFF_K = 2 * SHM_V, OFF_KR = OFF_K + 2 * SHM_K, OFF_WS = OFF_KR + 2 * SHM_KR, OFF_QR = OFF_WS + NW * 64 * 4, ATT_LDS = OFF_QR + NW * 8192;
constexpr int LDQN = 1024, LDQR = 512, LDK = 1024, LDKR = 64, LDO = 1024;

__device__ __forceinline__ void partialSM(f32x16& p0, f32x16& p1, float& m_reg, float& mn, float& alpha) {
    constexpr float C = SCALE * L2E;
    float pmax = p0[0];
#pragma unroll
    for (int r = 1; r < 16; ++r) pmax = fmaxf(pmax, p0[r]);
#pragma unroll
    for (int r = 0; r < 16; ++r) pmax = fmaxf(pmax, p1[r]);
    pmax = swap_max(pmax);
    if (__builtin_expect(__all(pmax - m_reg <= THR / SCALE), 1)) { mn = m_reg; alpha = 1.f; }
    else { mn = fmaxf(m_reg, pmax); alpha = __builtin_amdgcn_exp2f((m_reg - mn) * C); m_reg = mn; }
    const float mnC = -mn * C;
#pragma unroll
    for (int r = 0; r < 16; ++r) p0[r] = fmaf(p0[r], C, mnC);
#pragma unroll
    for (int r = 0; r < 16; ++r) p1[r] = fmaf(p1[r], C, mnC);
#pragma unroll
    for (int r = 0; r < 16; ++r) p0[r] = __builtin_amdgcn_exp2f(p0[r]);
}
__device__ __forceinline__ void finishSM(f32x16& p0, f32x16& p1, float alpha, float& l_reg, bf16x8& pa0, bf16x8& pa1, bf16x8& pa2, bf16x8& pa3) {
#pragma unroll
    for (int r = 0; r < 16; ++r) p1[r] = __builtin_amdgcn_exp2f(p1[r]);
    float ps = 0;
#pragma unroll
    for (int r = 0; r < 16; ++r) ps += p0[r];
#pragma unroll
    for (int r = 0; r < 16; ++r) ps += p1[r];
    ps = swap_add(ps);
    l_reg = l_reg * alpha + ps;
    PK4(p0, 0, pa0); PK4(p0, 8, pa1); PK4(p1, 0, pa2); PK4(p1, 8, pa3);
}
__device__ __forceinline__ void qkt(f32x16& p0, f32x16& p1, const char* Ks, const char* Krs, const bf16x8* qr, const char* qrl, int r32, int hi) {
#pragma unroll
    for (int r = 0; r < 16; ++r) { p0[r] = 0.f; p1[r] = 0.f; }
#pragma unroll
    for (int d0 = 0; d0 < 8; ++d0) { const int cb = (d0 * 16 + hi * 8) * 2;
        const bf16x8 b0 = *reinterpret_cast<const bf16x8*>(Ks + KSWZ(r32, cb));
        const bf16x8 b1 = *reinterpret_cast<const bf16x8*>(Ks + KSWZ(32 + r32, cb));
        bf16x8 qx; if (d0 < 4) qx = qr[d0]; else qx = *reinterpret_cast<const bf16x8*>(qrl + KRSWZ(r32, ((d0 - 4) * 16 + hi * 8) * 2));
        p0 = __builtin_amdgcn_mfma_f32_32x32x16_bf16(b0, qx, p0, 0, 0, 0);
        p1 = __builtin_amdgcn_mfma_f32_32x32x16_bf16(b1, qx, p1, 0, 0, 0); }
#pragma unroll
    for (int d0 = 0; d0 < 4; ++d0) { const int cb = (d0 * 16 + hi * 8) * 2;
        const bf16x8 b0 = *reinterpret_cast<const bf16x8*>(Krs + KRSWZ(r32, cb));
        const bf16x8 b1 = *reinterpret_cast<const bf16x8*>(Krs + KRSWZ(32 + r32, cb));
        const bf16x8 qx = *reinterpret_cast<const bf16x8*>(qrl + 4096 + KRSWZ(r32, cb));
        p0 = __builtin_amdgcn_mfma_f32_32x32x16_bf16(b0, qx, p0, 0, 0, 0);
        p1 = __builtin_amdgcn_mfma_f32_32x32x16_bf16(b1, qx, p1, 0, 0, 0); }
}
template <int D0> __device__ __forceinline__ void pv_one(f32x16& od, int vb, bf16x8 pa0, bf16x8 pa1, bf16x8 pa2, bf16x8 pa3) {
    const s16x4 l0 = tr_read<v_rd_off(D0, 0, 0)>(vb), h0 = tr_read<v_rd_off(D0, 0, 1)>(vb), l1 = tr_read<v_rd_off(D0, 1, 0)>(vb), h1 = tr_read<v_rd_off(D0, 1, 1)>(vb);
    const s16x4 l2 = tr_read<v_rd_off(D0, 2, 0)>(vb), h2 = tr_read<v_rd_off(D0, 2, 1)>(vb), l3 = tr_read<v_rd_off(D0, 3, 0)>(vb), h3 = tr_read<v_rd_off(D0, 3, 1)>(vb);
    asm volatile("s_waitcnt lgkmcnt(0)" ::: "memory"); SBAR();
    od = __builtin_amdgcn_mfma_f32_32x32x16_bf16(pa0, PKF(l0, h0), od, 0, 0, 0);
    od = __builtin_amdgcn_mfma_f32_32x32x16_bf16(pa1, PKF(l1, h1), od, 0, 0, 0);
    od = __builtin_amdgcn_mfma_f32_32x32x16_bf16(pa2, PKF(l2, h2), od, 0, 0, 0);
    od = __builtin_amdgcn_mfma_f32_32x32x16_bf16(pa3, PKF(l3, h3), od, 0, 0, 0);
}
__device__ __forceinline__ void pv_d0(f32x16* o, int vb, bf16x8 pa0, bf16x8 pa1, bf16x8 pa2, bf16x8 pa3) {
    pv_one<0>(o[0], vb, pa0, pa1, pa2, pa3); pv_one<1>(o[1], vb, pa0, pa1, pa2, pa3); pv_one<2>(o[2], vb, pa0, pa1, pa2, pa3); pv_one<3>(o[3], vb, pa0, pa1, pa2, pa3);
}
__device__ __forceinline__ void attn_unit(const bf16* Qn, const bf16* Qr, const bf16* Kn, const bf16* Kr, const bf16* Vh, bf16* Ob, char* lds) {
    const int tid = threadIdx.x, wid = tid >> 6, lane = tid & 63, r32 = lane & 31, hi = lane >> 5;
    char* V_lds = lds + OFF_V; char* K_lds = lds + OFF_K; char* KR_lds = lds + OFF_KR;
    float* ws = (float*)(lds + OFF_WS) + wid * 64; float* li_l = ws; float* al_l = ws + 32;
    float m_reg = -1e30f, l_reg = 0; f32x16 o[4]; bf16x8 qr[4]; char* qrl = lds + OFF_QR + wid * 8192;
#pragma unroll
    for (int d = 0; d < 4; ++d)
#pragma unroll
        for (int r = 0; r < 16; ++r) o[d][r] = 0.f;
    const bf16* Qw = Qn + (long)(wid * QBLK + r32) * LDQN + hi * 8;
    const bf16* Qw2 = Qr + (long)(wid * QBLK + r32) * LDQR + hi * 8;
#pragma unroll
    for (int d0 = 0; d0 < 4; ++d0) qr[d0] = *reinterpret_cast<const bf16x8*>(Qw + d0 * 16);
#pragma unroll
    for (int d0 = 4; d0 < 8; ++d0) *reinterpret_cast<bf16x8*>(qrl + KRSWZ(r32, ((d0 - 4) * 16 + hi * 8) * 2)) = *reinterpret_cast<const bf16x8*>(Qw + d0 * 16);
#pragma unroll
    for (int d0 = 0; d0 < 4; ++d0) *reinterpret_cast<bf16x8*>(qrl + 4096 + KRSWZ(r32, (d0 * 16 + hi * 8) * 2)) = *reinterpret_cast<const bf16x8*>(Qw2 + d0 * 16);
    const int sr = tid >> 4, sc = (tid & 15) * 8, vst0 = v_st(sr, sc), vst1 = v_st(32 + sr, sc);
    const int krr = tid >> 3, krc = (tid & 7) * 8;
    const int vb0 = (int)(uintptr_t)V_lds + v_rd_base(lane);
    bf16x8 vs0, vs1, ks0, ks1, krs;
    const unsigned offkv = (unsigned)(sr * LDK + sc), offkr = (unsigned)(krr * LDKR + krc);
#define SLOAD(k0) do { const bf16* vt_ = Vh + (size_t)(k0) * LDK; const bf16* kt_ = Kn + (size_t)(k0) * LDK; const bf16* rt_ = Kr + (size_t)(k0) * LDKR; \
    vs0 = *reinterpret_cast<const bf16x8*>(vt_ + offkv); vs1 = *reinterpret_cast<const bf16x8*>(vt_ + offkv + 32 * LDK); \
    ks0 = *reinterpret_cast<const bf16x8*>(kt_ + offkv); ks1 = *reinterpret_cast<const bf16x8*>(kt_ + offkv + 32 * LDK); \
    krs = *reinterpret_cast<const bf16x8*>(rt_ + offkr); } while (0)
#define SWRITE(b) do { *(bf16x8*)(V_lds + (b) * SHM_V + vst0) = vs0; *(bf16x8*)(V_lds + (b) * SHM_V + vst1) = vs1; const int kc = sc * 2; \
    *(bf16x8*)(K_lds + (b) * SHM_K + KSWZ(sr, kc)) = ks0; *(bf16x8*)(K_lds + (b) * SHM_K + KSWZ(32 + sr, kc)) = ks1; \
    *(bf16x8*)(KR_lds + (b) * SHM_KR + KRSWZ(krr, krc * 2)) = krs; } while (0)
#define SWAIT() asm volatile("s_waitcnt vmcnt(0)" ::: "memory")
#define RESC(a) do { if (__any((a) < 1.f)) { if (hi == 0) al_l[r32] = (a); asm volatile("s_waitcnt lgkmcnt(0)" ::: "memory"); \
    _Pragma("unroll") for (int d = 0; d < 4; ++d) _Pragma("unroll") for (int r = 0; r < 16; ++r) o[d][r] *= al_l[crow(r, hi)]; } } while (0)
    f32x16 pA0, pA1, pB0, pB1; float mnA, mnB, alA, alB; bf16x8 pa0, pa1, pa2, pa3; constexpr int NT = SEQ / KVBLK;
    __syncthreads();
    SLOAD(0); SWAIT(); SWRITE(0); __syncthreads();
    qkt(pA0, pA1, K_lds, KR_lds, qr, qrl, r32, hi); partialSM(pA0, pA1, m_reg, mnA, alA);
    SLOAD(KVBLK);
    SWAIT(); SWRITE(1); __syncthreads();
    for (int j = 1; j + 1 < NT; j += 2) {
        SBAR(); qkt(pB0, pB1, K_lds + SHM_K, KR_lds + SHM_KR, qr, qrl, r32, hi);
        finishSM(pA0, pA1, alA, l_reg, pa0, pa1, pa2, pa3); SBAR();
        SLOAD((j + 1) * KVBLK); SBAR();
        pv_d0(o, vb0, pa0, pa1, pa2, pa3); partialSM(pB0, pB1, m_reg, mnB, alB);
        __syncthreads(); SWAIT(); SWRITE(0);
        RESC(alB); __syncthreads();
        SBAR(); qkt(pA0, pA1, K_lds, KR_lds, qr, qrl, r32, hi);
        finishSM(pB0, pB1, alB, l_reg, pa0, pa1, pa2, pa3); SBAR();
        SLOAD((j + 2) * KVBLK); SBAR();
        pv_d0(o, vb0 + SHM_V, pa0, pa1, pa2, pa3); partialSM(pA0, pA1, m_reg, mnA, alA);
        __syncthreads(); SWAIT(); SWRITE(1);
        RESC(alA); __syncthreads();
    }
    SBAR(); qkt(pB0, pB1, K_lds + SHM_K, KR_lds + SHM_KR, qr, qrl, r32, hi);
    finishSM(pA0, pA1, alA, l_reg, pa0, pa1, pa2, pa3); SBAR();
    pv_d0(o, vb0, pa0, pa1, pa2, pa3); partialSM(pB0, pB1, m_reg, mnB, alB);
    __syncthreads(); RESC(alB);
    finishSM(pB0, pB1, alB, l_reg, pa0, pa1, pa2, pa3); SBAR();
    pv_d0(o, vb0 + SHM_V, pa0, pa1, pa2, pa3);
    if (hi == 0) li_l[r32] = l_reg; asm volatile("s_waitcnt lgkmcnt(0)" ::: "memory");
    {
        int le = lane; asm volatile("" : "+v"(le)); const int r32e = le & 31, hie = le >> 5;
        float rli[16];
#pragma unroll
        for (int r = 0; r < 16; ++r) rli[r] = __builtin_amdgcn_rcpf(li_l[crow(r, hie)]);
        bf16* Ow = Ob + (size_t)(__builtin_amdgcn_readfirstlane(wid) * QBLK) * LDO;
        const unsigned ob = (unsigned)(4 * hie * LDO + r32e);
#pragma unroll
        for (int r = 0; r < 16; ++r) { const unsigned orow = (unsigned)((r & 3) + 8 * (r >> 2));
#pragma unroll
            for (int d0 = 0; d0 < 4; ++d0) Ow[ob + orow * LDO + d0 * 32] = (bf16)(cvtpk(o[d0][r] * rli[r], 0.f) & 0xffffu); }
    }
#undef SLOAD
#undef SWRITE
#undef SWAIT
#undef RESC
}
}

namespace ml {
constexpr int QIMG = 0, KIMG = 16384, KAIMG = 32768, VIMG = 49152, NIMG = 81920, WSCR = 98304, ML_LDS = 114688;
__device__ __forceinline__ float scan_add(float x, int lane) {
#pragma unroll
    for (int o = 1; o < 64; o <<= 1) { const float y = __shfl_up(x, o); if (lane >= o) x += y; }
    return x;
}
__device__ __forceinline__ float scan_max(float x, int lane) {
#pragma unroll
    for (int o = 1; o < 64; o <<= 1) { const float y = __shfl_up(x, o); if (lane >= o) x = fmaxf(x, y); }
    return x;
}
__device__ __forceinline__ bf16x8 pack_step(const f32x16& x, int s) {
    v4u p; p.x = cvtpk(x[8 * s + 0], x[8 * s + 1]); p.y = cvtpk(x[8 * s + 2], x[8 * s + 3]); p.z = cvtpk(x[8 * s + 4], x[8 * s + 5]); p.w = cvtpk(x[8 * s + 6], x[8 * s + 7]);
    return __builtin_bit_cast(bf16x8, p);
}
template <int D0> __device__ __forceinline__ bf16x8 tr_frag(int vb, int ksoff) {
    const s16x4 l = tr_read<v_rd_off(D0, 0, 0)>(vb + ksoff), h = tr_read<v_rd_off(D0, 0, 1)>(vb + ksoff);
    return PKF(l, h);
}

struct Ctx {
    char* lds; int wid, lane, r32, hi, cur;
    float* U; float* Mx; float* WI; float* EN; float* RA;
};

template <int B>
__device__ __forceinline__ void ttile(const Ctx& X, const f32x16 (&C)[4], int vbV, f32x16& hout) {
    const int r32 = X.r32, hi = X.hi; const char* lds = X.lds;
#define QF(ks) (*reinterpret_cast<const bf16x8*>(lds + QIMG + KSWZ(32 * B + r32, ((ks) * 16 + hi * 8) * 2)))
    float qn;
    {   f32x16 pn;
#pragma unroll
        for (int r = 0; r < 16; ++r) pn[r] = 0.f;
#pragma unroll
        for (int ks = 0; ks < 8; ++ks) { const bf16x8 nf = *reinterpret_cast<const bf16x8*>(lds + NIMG + X.cur * 8192 + KSWZ(r32, (ks * 16 + hi * 8) * 2));
            pn = __builtin_amdgcn_mfma_f32_32x32x16_bf16(nf, QF(ks), pn, 0, 0, 0); }
        qn = swap_add(pn[0]); }
    SBAR();
    f32x16 o2;
#pragma unroll
    for (int r = 0; r < 16; ++r) o2[r] = 0.f;
#pragma unroll
    for (int dt = 0; dt < 4; ++dt)
#pragma unroll
        for (int s = 0; s < 2; ++s) o2 = __builtin_amdgcn_mfma_f32_32x32x16_bf16(QF(2 * dt + s), pack_step(C[dt], s), o2, 0, 0, 0);
    SBAR();
    f32x16 p0, p1;
#pragma unroll
    for (int r = 0; r < 16; ++r) { p0[r] = 0.f; p1[r] = 0.f; }
#pragma unroll
    for (int ks = 0; ks < 8; ++ks) { const int cb = (ks * 16 + hi * 8) * 2;
        const bf16x8 k0 = *reinterpret_cast<const bf16x8*>(lds + KIMG + KSWZ(r32, cb)); const bf16x8 qx = QF(ks);
        p0 = __builtin_amdgcn_mfma_f32_32x32x16_bf16(k0, qx, p0, 0, 0, 0);
        if (B == 1) { const bf16x8 k1 = *reinterpret_cast<const bf16x8*>(lds + KIMG + KSWZ(32 + r32, cb));
            p1 = __builtin_amdgcn_mfma_f32_32x32x16_bf16(k1, qx, p1, 0, 0, 0); }
        if (ks == 3) SBAR(); }
    SBAR();
    const int t = 32 * B + r32; const float Mt = X.Mx[t];
    float rs = 0.f;
#pragma unroll
    for (int g = 0; g < 4; ++g) { const f32x4 u4 = *reinterpret_cast<const f32x4*>(X.U + 8 * g + 4 * hi);
#pragma unroll
        for (int i = 0; i < 4; ++i) { const int s = 8 * g + 4 * hi + i; float w = __builtin_amdgcn_exp2f((u4[i] - Mt) * L2E); if (B == 0 && s > r32) w = 0.f; p0[4 * g + i] *= w; rs += p0[4 * g + i]; } }
    if (B == 1) {
#pragma unroll
        for (int g = 0; g < 4; ++g) { const f32x4 u4 = *reinterpret_cast<const f32x4*>(X.U + 32 + 8 * g + 4 * hi);
#pragma unroll
            for (int i = 0; i < 4; ++i) { const int s = 8 * g + 4 * hi + i; float w = __builtin_amdgcn_exp2f((u4[i] - Mt) * L2E); if (s > r32) w = 0.f; p1[4 * g + i] *= w; rs += p1[4 * g + i]; } }
    }
    rs = swap_add(rs);
    const float wi = X.WI[t], den = rs + wi * qn;
    const float inv = __builtin_amdgcn_rcpf(fmaxf(fabsf(den), X.EN[t]));
    if (hi == 0) X.RA[t] = wi * inv;
#pragma unroll
    for (int r = 0; r < 16; ++r) { p0[r] *= inv; if (B == 1) p1[r] *= inv; }
    bf16x8 pa0, pa1, pa2, pa3;
    PK4(p0, 0, pa0); PK4(p0, 8, pa1);
    f32x16 o;
#pragma unroll
    for (int r = 0; r < 16; ++r) o[r] = 0.f;
    bf16x8 Vf[4];
    { const s16x4 l0 = tr_read<v_rd_off(0, 0, 0)>(vbV), h0 = tr_read<v_rd_off(0, 0, 1)>(vbV), l1 = tr_read<v_rd_off(0, 1, 0)>(vbV), h1 = tr_read<v_rd_off(0, 1, 1)>(vbV);
      s16x4 l2 = l0, h2 = h0, l3 = l1, h3 = h1;
      if (B == 1) { l2 = tr_read<v_rd_off(0, 2, 0)>(vbV); h2 = tr_read<v_rd_off(0, 2, 1)>(vbV); l3 = tr_read<v_rd_off(0, 3, 0)>(vbV); h3 = tr_read<v_rd_off(0, 3, 1)>(vbV); }
      asm volatile("s_waitcnt lgkmcnt(0)" ::: "memory"); SBAR();
      Vf[0] = PKF(l0, h0); Vf[1] = PKF(l1, h1); Vf[2] = PKF(l2, h2); Vf[3] = PKF(l3, h3); }
    o = __builtin_amdgcn_mfma_f32_32x32x16_bf16(pa0, Vf[0], o, 0, 0, 0);
    o = __builtin_amdgcn_mfma_f32_32x32x16_bf16(pa1, Vf[1], o, 0, 0, 0);
    if (B == 1) { PK4(p1, 0, pa2); PK4(p1, 8, pa3);
        o = __builtin_amdgcn_mfma_f32_32x32x16_bf16(pa2, Vf[2], o, 0, 0, 0);
        o = __builtin_amdgcn_mfma_f32_32x32x16_bf16(pa3, Vf[3], o, 0, 0, 0); }
    asm volatile("s_waitcnt lgkmcnt(0)" ::: "memory");
#pragma unroll
    for (int g = 0; g < 4; ++g) { const f32x4 ra = *reinterpret_cast<const f32x4*>(X.RA + 32 * B + 8 * g + 4 * hi);
#pragma unroll
        for (int i = 0; i < 4; ++i) hout[4 * g + i] = o[4 * g + i] + ra[i] * o2[4 * g + i]; }
#undef QF
}

__device__ __forceinline__ void mlstm_unit(int seqbase, int dir, int h, const bf16* QKc, const bf16* Vg, const float* Gt, bf16* HM, char* lds) {
    const int tid = threadIdx.x, wid = tid >> 6, lane = tid & 63, r32 = lane & 31, hi = lane >> 5;
    float* wsp = (float*)(lds + WSCR + wid * 2048);
    Ctx X; X.lds = lds; X.wid = wid; X.lane = lane; X.r32 = r32; X.hi = hi; X.cur = 0; X.U = wsp; X.Mx = wsp + 64; X.WI = wsp + 128; X.EN = wsp + 192; X.RA = wsp + 256;
    { const v4u z = {0u, 0u, 0u, 0u}; ((v4u*)(lds + NIMG))[tid] = z; ((v4u*)(lds + NIMG))[tid + 512] = z; }
    f32x16 C[4];
#pragma unroll
    for (int d = 0; d < 4; ++d)
#pragma unroll
        for (int r = 0; r < 16; ++r) C[d][r] = 0.f;
    float nreg = 0.f, m = 0.f;
    const int ss = tid >> 3, seg = tid & 7;
    const int vbK = (int)(uintptr_t)(lds + KAIMG) + v_rd_base(lane);
    const int vbV = (int)(uintptr_t)(lds + VIMG + (wid >> 2) * 16384) + v_rd_base(lane) + (wid & 3) * 512;
    v4u sq0, sq1, sk0, sk1, sv0, sv1, sv2, sv3; float gi, gf;
#define ROWOF(c, j) (seqbase + (dir ? (SEQ - 1 - ((c) * 64 + (j))) : ((c) * 64 + (j))))
#define MLOAD(c) do { const long row_ = ROWOF(c, ss); const bf16* qp_ = QKc + row_ * 1024 + h * 128 + 16 * seg; const bf16* vp_ = Vg + row_ * 1024 + h * 256 + 32 * seg; \
    sq0 = *(const GAS v4u*)qp_; sq1 = *(const GAS v4u*)(qp_ + 8); sk0 = *(const GAS v4u*)(qp_ + 512); sk1 = *(const GAS v4u*)(qp_ + 520); \
    sv0 = *(const GAS v4u*)vp_; sv1 = *(const GAS v4u*)(vp_ + 8); sv2 = *(const GAS v4u*)(vp_ + 16); sv3 = *(const GAS v4u*)(vp_ + 24); \
    const float* gp_ = Gt + (long)ROWOF(c, lane) * 16 + 4 * dir + h; gi = gp_[0]; gf = gp_[8]; } while (0)
    MLOAD(0);
    for (int c = 0; c < SEQ / 64; ++c) {
        const float b = scan_add(gf, lane), u = gi - b, cm = scan_max(u, lane), Mj = fmaxf(m, cm);
        const float M63 = __shfl(Mj, 63), blast = __shfl(b, 63);
        const float e = fexp(u - M63), a = fexp(m - M63);
        X.U[lane] = u; X.Mx[lane] = Mj; X.WI[lane] = fexp(m - Mj); X.EN[lane] = fexp(-(b + Mj));
        const float es = __shfl(e, 8 * wid + (lane >> 3));
        m = blast + M63;
        __syncthreads();
        {
            *(v4u*)(lds + QIMG + KSWZ(ss, (16 * seg) * 2)) = sq0; *(v4u*)(lds + QIMG + KSWZ(ss, (16 * seg + 8) * 2)) = sq1;
            *(v4u*)(lds + KIMG + KSWZ(ss, (16 * seg) * 2)) = sk0; *(v4u*)(lds + KIMG + KSWZ(ss, (16 * seg + 8) * 2)) = sk1;
            f32x4 a0, a1, b0, b1; unpk8(sk0, a0, a1); unpk8(sk1, b0, b1);
            a0 *= es; a1 *= es; b0 *= es; b1 *= es;
            *(v4u*)(lds + KAIMG + v_st(ss, 16 * seg)) = pk8g(a0, b0); *(v4u*)(lds + KAIMG + v_st(ss, 16 * seg + 8)) = pk8g(a1, b1);
            char* vi = lds + VIMG + (seg >> 2) * 16384; const int vc = 32 * (seg & 3);
            *(v4u*)(vi + v_st(ss, vc)) = sv0; *(v4u*)(vi + v_st(ss, vc + 8)) = sv1; *(v4u*)(vi + v_st(ss, vc + 16)) = sv2; *(v4u*)(vi + v_st(ss, vc + 24)) = sv3;
        }
        __syncthreads();
        X.cur = c & 1;
        {
            bf16* hp = HM + (long)h * 256 + 32 * wid + r32;
            f32x16 hv;
            ttile<0>(X, C, vbV, hv);
#pragma unroll
            for (int r = 0; r < 16; ++r) hp[(long)ROWOF(c, crow(r, hi)) * 1024] = (bf16)(cvtpk(hv[r], 0.f) & 0xffffu);
            SBAR();
            ttile<1>(X, C, vbV, hv);
#pragma unroll
            for (int r = 0; r < 16; ++r) hp[(long)ROWOF(c, 32 + crow(r, hi)) * 1024] = (bf16)(cvtpk(hv[r], 0.f) & 0xffffu);
            SBAR();
        }
        if (c + 1 < SEQ / 64) MLOAD(c + 1);
        float nsum = 0.f;
        bf16x8 Vf[4];
        { const s16x4 l0 = tr_read<v_rd_off(0, 0, 0)>(vbV), h0 = tr_read<v_rd_off(0, 0, 1)>(vbV), l1 = tr_read<v_rd_off(0, 1, 0)>(vbV), h1 = tr_read<v_rd_off(0, 1, 1)>(vbV);
          const s16x4 l2 = tr_read<v_rd_off(0, 2, 0)>(vbV), h2 = tr_read<v_rd_off(0, 2, 1)>(vbV), l3 = tr_read<v_rd_off(0, 3, 0)>(vbV), h3 = tr_read<v_rd_off(0, 3, 1)>(vbV);
          asm volatile("s_waitcnt lgkmcnt(0)" ::: "memory"); SBAR();
          Vf[0] = PKF(l0, h0); Vf[1] = PKF(l1, h1); Vf[2] = PKF(l2, h2); Vf[3] = PKF(l3, h3); }
#define CUPD(DT) do { \
        bf16x8 f0_, f1_, f2_, f3_; \
        { const s16x4 l0 = tr_read<v_rd_off(DT, 0, 0)>(vbK), h0 = tr_read<v_rd_off(DT, 0, 1)>(vbK), l1 = tr_read<v_rd_off(DT, 1, 0)>(vbK), h1 = tr_read<v_rd_off(DT, 1, 1)>(vbK); \
          const s16x4 l2 = tr_read<v_rd_off(DT, 2, 0)>(vbK), h2 = tr_read<v_rd_off(DT, 2, 1)>(vbK), l3 = tr_read<v_rd_off(DT, 3, 0)>(vbK), h3 = tr_read<v_rd_off(DT, 3, 1)>(vbK); \
          asm volatile("s_waitcnt lgkmcnt(0)" ::: "memory"); SBAR(); \
          f0_ = PKF(l0, h0); f1_ = PKF(l1, h1); f2_ = PKF(l2, h2); f3_ = PKF(l3, h3); } \
        _Pragma("unroll") for (int r = 0; r < 16; ++r) C[DT][r] *= a; \
        C[DT] = __builtin_amdgcn_mfma_f32_32x32x16_bf16(f0_, Vf[0], C[DT], 0, 0, 0); C[DT] = __builtin_amdgcn_mfma_f32_32x32x16_bf16(f1_, Vf[1], C[DT], 0, 0, 0); \
        C[DT] = __builtin_amdgcn_mfma_f32_32x32x16_bf16(f2_, Vf[2], C[DT], 0, 0, 0); C[DT] = __builtin_amdgcn_mfma_f32_32x32x16_bf16(f3_, Vf[3], C[DT], 0, 0, 0); \
        if (wid == DT) { const v4u q0 = __builtin_bit_cast(v4u, f0_), q1 = __builtin_bit_cast(v4u, f1_), q2 = __builtin_bit_cast(v4u, f2_), q3 = __builtin_bit_cast(v4u, f3_); \
            _Pragma("unroll") for (int i = 0; i < 4; ++i) nsum += (bflo(q0[i]) + bfhi(q0[i])) + (bflo(q1[i]) + bfhi(q1[i])) + (bflo(q2[i]) + bfhi(q2[i])) + (bflo(q3[i]) + bfhi(q3[i])); } \
        } while (0)
        CUPD(0); CUPD(1); CUPD(2); CUPD(3);
        if (wid < 4) {
            nsum = swap_add(nsum); nreg = a * nreg + nsum;
            if (hi == 0) { const int p = sig16(32 * wid + r32); *(bf16*)(lds + NIMG + ((c + 1) & 1) * 8192 + KSWZ(0, p * 2)) = (bf16)(cvtpk(nreg, 0.f) & 0xffffu); }
        }
    }
#undef CUPD
#undef MLOAD
#undef ROWOF
}
}

#define EPI_ARGS int row, int col, f32x4 a0, f32x4 a1, f32x4 b0, f32x4 b1, int pn, int wc, int fq
__device__ __forceinline__ void st8(bf16* p, f32x4 a, f32x4 b) { *(GAS v4u*)p = pk8g(a, b); }
__device__ __forceinline__ void ld8(const bf16* p, f32x4& a, f32x4& b) { unpk8(*(const GAS v4u*)p, a, b); }
__device__ __forceinline__ float sq8(f32x4 a, f32x4 b) { return (a[0] * a[0] + a[1] * a[1]) + (a[2] * a[2] + a[3] * a[3]) + (b[0] * b[0] + b[1] * b[1]) + (b[2] * b[2] + b[3] * b[3]); }
__device__ __forceinline__ void rope8(const f32x2g* tab, int pos, int i0, f32x4& a0, f32x4& a1) {
    const f32x4 c01 = *(const GAS f32x4*)(tab + pos * 32 + i0), c23 = *(const GAS f32x4*)(tab + pos * 32 + i0 + 2);
    f32x4 r0, r1;
    r0[0] = a0[0] * c01[0] - a0[1] * c01[1]; r0[1] = a0[0] * c01[1] + a0[1] * c01[0];
    r0[2] = a0[2] * c01[2] - a0[3] * c01[3]; r0[3] = a0[2] * c01[3] + a0[3] * c01[2];
    r1[0] = a1[0] * c23[0] - a1[1] * c23[1]; r1[1] = a1[0] * c23[1] + a1[1] * c23[0];
    r1[2] = a1[2] * c23[2] - a1[3] * c23[3]; r1[3] = a1[2] * c23[3] + a1[3] * c23[2];
    a0 = r0; a1 = r1;
}
__device__ __forceinline__ float log_sigmoid(float x) { return fminf(x, 0.f) - logf(1.f + expf(-fabsf(x))); }

struct FIn {
    bf16 *qkraw, *vv, *osig, *gm, *cq, *ckv, *kr; float *gates, *ssqq, *ssqkv; const f32x2g* tab; const float* bgate;
    __device__ __forceinline__ void operator()(EPI_ARGS) const {
        if (pn < 8) { bf16* p = (pn < 4 ? qkraw : vv) + (size_t)row * 1024 + (col & 1023); st8(p, a0, a1); st8(p + 128, b0, b1); }
        else if (pn < 12) { bf16* p = osig + (size_t)row * 1024 + (col - 2048); st8(p, sig4(a0), sig4(a1)); st8(p + 128, sig4(b0), sig4(b1)); }
        else if (pn < 20) { bf16* p = gm + (size_t)row * 2048 + (col - 3072); st8(p, sig4(a0), sig4(a1)); st8(p + 128, sig4(b0), sig4(b1)); }
        else if (pn < 22) { bf16* p = (pn == 20 ? cq : ckv) + (size_t)row * 256 + (col & 255); st8(p, a0, a1); st8(p + 128, b0, b1);
            float s = sq8(a0, a1) + sq8(b0, b1); s += __shfl_xor(s, 16); s += __shfl_xor(s, 32);
            if (fq == 0) (pn == 20 ? ssqq : ssqkv)[(size_t)row * 4 + wc] = s; }
        else { const int j = col - 5632;
            if (j < 64) { rope8(tab, row & (SEQ - 1), j >> 1, a0, a1); st8(kr + (size_t)row * 64 + j, a0, a1); }
            else if (j < 80) { const f32x4 g0 = *(const GAS f32x4*)(bgate + (j - 64)), g1 = *(const GAS f32x4*)(bgate + (j - 64) + 4);
                a0 += g0; a1 += g1;
                if (j == 72) {
#pragma unroll
                    for (int k = 0; k < 4; ++k) { a0[k] = log_sigmoid(a0[k]); a1[k] = log_sigmoid(a1[k]); } }
                float* gp = gates + (size_t)row * 16 + (j - 64); *(GAS f32x4*)gp = a0; *(GAS f32x4*)(gp + 4) = a1; }
        }
    }
};
struct FQ {
    bf16 *qn, *qr; const float* ssq; const f32x2g* tab;
    __device__ __forceinline__ void operator()(EPI_ARGS) const {
        const f32x4 s4 = *(const GAS f32x4*)(ssq + (size_t)row * 4); const float rstd = 1.0f / sqrtf(((s4[0] + s4[1]) + (s4[2] + s4[3])) * (1.f / 256.f) + EPS);
        a0 *= rstd; a1 *= rstd; b0 *= rstd; b1 *= rstd;
        if (pn < 4) { bf16* p = qn + (size_t)row * 1024 + col; st8(p, a0, a1); st8(p + 128, b0, b1); }
        else { const int c = col - 1024, i0 = (c & 63) >> 1, pos = row & (SEQ - 1); rope8(tab, pos, i0, a0, a1); rope8(tab, pos, i0, b0, b1);
            bf16* p = qr + (size_t)row * 512 + c; st8(p, a0, a1); st8(p + 128, b0, b1); }
    }
};
struct FKV {
    bf16 *kn, *va; const float* ssq;
    __device__ __forceinline__ void operator()(EPI_ARGS) const {
        const f32x4 s4 = *(const GAS f32x4*)(ssq + (size_t)row * 4); const float rstd = 1.0f / sqrtf(((s4[0] + s4[1]) + (s4[2] + s4[3])) * (1.f / 256.f) + EPS);
        a0 *= rstd; a1 *= rstd; b0 *= rstd; b1 *= rstd;
        bf16* p = (pn < 4 ? kn : va) + (size_t)row * 1024 + (col & 1023); st8(p, a0, a1); st8(p + 128, b0, b1);
    }
};
struct FE1 {
    bf16* t; const bf16* gm;
    __device__ __forceinline__ void operator()(EPI_ARGS) const {
        f32x4 g0, g1, g2, g3; const bf16* g = gm + (size_t)row * 2048 + col; ld8(g, g0, g1); ld8(g + 128, g2, g3);
        bf16* p = t + (size_t)row * 1024 + col; st8(p, a0 * g0, a1 * g1); st8(p + 128, b0 * g2, b1 * g3);
    }
};
struct FPlain { bf16* o;
    __device__ __forceinline__ void operator()(EPI_ARGS) const { bf16* p = o + (size_t)row * 1024 + col; st8(p, a0, a1); st8(p + 128, b0, b1); }
};
struct FE2 {
    bf16* mg; const bf16* t; const bf16* gm;
    __device__ __forceinline__ void operator()(EPI_ARGS) const {
        f32x4 g0, g1, g2, g3, t0, t1, t2, t3; const bf16* g = gm + (size_t)row * 2048 + 1024 + col; ld8(g, g0, g1); ld8(g + 128, g2, g3);
        const bf16* tp = t + (size_t)row * 1024 + col; ld8(tp, t0, t1); ld8(tp + 128, t2, t3);
        bf16* p = mg + (size_t)row * 1024 + col; st8(p, t0 + a0 * g0, t1 + a1 * g1); st8(p + 128, t2 + b0 * g2, t3 + b1 * g3);
    }
};
struct FE3 {
    const float *xp, *xs; float* out; bf16* xb; float* ssq;
    __device__ __forceinline__ void operator()(EPI_ARGS) const {
        const float* xr = (row < MP ? xp + (size_t)row * DM : xs + (size_t)(row - MP) * DM) + col;
        a0 += *(const GAS f32x4*)xr; a1 += *(const GAS f32x4*)(xr + 4); b0 += *(const GAS f32x4*)(xr + 128); b1 += *(const GAS f32x4*)(xr + 132);
        float* op = out + (size_t)row * DM + col; *(GAS f32x4*)op = a0; *(GAS f32x4*)(op + 4) = a1; *(GAS f32x4*)(op + 128) = b0; *(GAS f32x4*)(op + 132) = b1;
        bf16* p = xb + (size_t)row * 1024 + col; st8(p, a0, a1); st8(p + 128, b0, b1);
        float s = sq8(a0, a1) + sq8(b0, b1); s += __shfl_xor(s, 16); s += __shfl_xor(s, 32);
        if (fq == 0) ssq[(size_t)row * 16 + pn * 4 + wc] = s;
    }
};
struct FF1 {
    bf16* gu; const float* ssq;
    __device__ __forceinline__ void operator()(EPI_ARGS) const {
        const float* sp = ssq + (size_t)row * 16; const f32x4 s0 = *(const GAS f32x4*)sp, s1 = *(const GAS f32x4*)(sp + 4), s2 = *(const GAS f32x4*)(sp + 8), s3 = *(const GAS f32x4*)(sp + 12);
        const f32x4 st = (s0 + s1) + (s2 + s3); const float rstd = 1.0f / sqrtf(((st[0] + st[1]) + (st[2] + st[3])) * (1.f / DM) + EPS);
        f32x4 r0, r1;
#pragma unroll
        for (int k = 0; k < 4; ++k) { const float g0 = a0[k] * rstd, g1 = a1[k] * rstd; r0[k] = g0 * fsigmoid(g0) * (b0[k] * rstd); r1[k] = g1 * fsigmoid(g1) * (b1[k] * rstd); }
        st8(gu + (size_t)row * DFF + (col - 128 * pn), r0, r1);
    }
};
struct FF2 {
    float* out; bf16* xb;
    __device__ __forceinline__ void operator()(EPI_ARGS) const {
        float* op = out + (size_t)row * DM + col;
        a0 += *(const GAS f32x4*)op; a1 += *(const GAS f32x4*)(op + 4); b0 += *(const GAS f32x4*)(op + 128); b1 += *(const GAS f32x4*)(op + 132);
        *(GAS f32x4*)op = a0; *(GAS f32x4*)(op + 4) = a1; *(GAS f32x4*)(op + 128) = b0; *(GAS f32x4*)(op + 132) = b1;
        bf16* p = xb + (size_t)row * 1024 + col; st8(p, a0, a1); st8(p + 128, b0, b1);
    }
};
struct FG1 {
    float* out; const bf16* y2;
    __device__ __forceinline__ void operator()(EPI_ARGS) const {
        f32x4 y0, y1, y2v, y3; const bf16* yp = y2 + (size_t)row * 1024 + col; ld8(yp, y0, y1); ld8(yp + 128, y2v, y3);
        float* op = out + (size_t)row * DM + col;
        a0 = *(const GAS f32x4*)op + sig4(a0) * y0; a1 = *(const GAS f32x4*)(op + 4) + sig4(a1) * y1; b0 = *(const GAS f32x4*)(op + 128) + sig4(b0) * y2v; b1 = *(const GAS f32x4*)(op + 132) + sig4(b1) * y3;
        *(GAS f32x4*)op = a0; *(GAS f32x4*)(op + 4) = a1; *(GAS f32x4*)(op + 128) = b0; *(GAS f32x4*)(op + 132) = b1;
    }
};
template <class F> __device__ __forceinline__ void run_gemm(LAS unsigned char* lds, const bf16* A, const bf16* Bt, int N, int K, int G, const F& f) {
    asm volatile("" : "+s"(K));
    pg8::Gemm g{A, Bt, M, N, K}; pg8::StaticOrder S; S.init(M, N, G, (int)blockIdx.x); pg8::Epi8<F> E{f};
    pg8::gemm_phase<pg8::Epi8<F>, pg8::StaticOrder, true, true>(lds, g, S, E);
}

#ifndef MK_N_LAUNCHES
#define MK_N_LAUNCHES 1
#endif
constexpr int N_PHASES = 14;
struct Args { const float* in[23]; float* out; unsigned char* ws; int ph_lo, ph_hi; };
__device__ __forceinline__ const float* in_ptr(int k) {
    const char* ka = (const char*)__builtin_amdgcn_kernarg_segment_ptr(); asm volatile("" : "+s"(ka));
    return *(const float* const*)(ka + 8 * k);
}
__global__ void __launch_bounds__(NWAVES * 64, 2) fwd_kernel(Args args) {
    extern __shared__ __attribute__((aligned(16))) unsigned char lds[];
    LAS unsigned char* L = (LAS unsigned char*)lds;
    volatile LAS unsigned* MISC = (volatile LAS unsigned*)(L + MISC_OFF);
    const int tid = threadIdx.x, wave = __builtin_amdgcn_readfirstlane(tid >> 6);
    const int G = gridDim.x, bx = blockIdx.x, vcu = (G % 8 == 0) ? (bx % 8) * (G / 8) + bx / 8 : bx;
    const int gw = vcu * NWAVES + wave, NGW = G * NWAVES;
    unsigned char* ws = args.ws;
    for (int u = tid; u < (LDS_BYTES - PHASE_LDS) / 4; u += NWAVES * 64) ((LAS unsigned*)(L + PHASE_LDS))[u] = 0u;
    static_assert(att::ATT_LDS <= PHASE_LDS && ml::ML_LDS <= PHASE_LDS, "phase scratch");
    __syncthreads();
    XcdBarrier bar = xcd_barrier_post((unsigned*)(ws + WS_CTL) + CW_BAR, MISC + 8);
    bf16 *R1 = (bf16*)(ws + WS_R1), *R2 = (bf16*)(ws + WS_R2), *R3 = (bf16*)(ws + WS_R3), *R4 = (bf16*)(ws + WS_R4), *R5 = (bf16*)(ws + WS_R5);
    bf16 *CQ = (bf16*)(ws + WS_CQ), *CKV = (bf16*)(ws + WS_CKV), *KR = (bf16*)(ws + WS_KR), *PB = (bf16*)(ws + WS_PB);
    float *GT = (float*)(ws + WS_G), *SSQQ = (float*)(ws + WS_SSQQ), *SSQKV = (float*)(ws + WS_SSQKV), *SSQ1 = (float*)(ws + WS_SSQ1);
    const f32x2g* TAB = (const f32x2g*)(ws + WS_TAB);
    bf16* GM = (bf16*)args.out;
    const int PH_LO = args.ph_lo, PH_HI = args.ph_hi;
#ifdef ONLY_PHASE
#define PH(k) if ((k) == ONLY_PHASE)
#else
#define PH(k) if (PH_LO <= (k) && (k) < PH_HI)
#endif
#define SEAM(k) do { if (PH_LO <= (k) && (k) + 1 < PH_HI) xcd_barrier(bar); } while (0)

    PH(0) { p0_prologue(ws, L, vcu, G, wave, lane_id(), tid); } SEAM(0);
    PH(1) { FIn f{R2, R3, R4, GM, CQ, CKV, KR, GT, SSQQ, SSQKV, TAB, in_ptr(6)}; run_gemm(L, R1, (const bf16*)(ws + WS_WIN), NIN, 1024, G, f); } SEAM(1);
    PH(2) { t1_conv(R2, R1, in_ptr(7), gw, NGW, lane_id()); } SEAM(2);
    PH(3) { if (vcu < NSEQ * 8) { const int sq = vcu >> 3, dir = (vcu >> 2) & 1, hh = vcu & 3; ml::mlstm_unit(sq * SEQ, dir, hh, R1, R3, GT, dir ? R5 : R2, (char*)lds); } } SEAM(3);
    PH(4) { t2_combine(R2, R5, R4, in_ptr(8), gw, NGW, lane_id()); } SEAM(4);
    PH(5) { { FQ f{R1, R2, SSQQ, TAB}; run_gemm(L, CQ, (const bf16*)(ws + WS_WUQ), 1536, 256, G, f); }
            { FKV f{R3, R5, SSQKV}; run_gemm(L, CKV, (const bf16*)(ws + WS_WUKV), 2048, 256, G, f); } } SEAM(5);
    PH(6) { for (int g = vcu; g < NSEQ * 8 * 16; g += G) {
                const int bh = g >> 4, qb = g & 15, sq = bh >> 3, hh = bh & 7; const size_t r0 = (size_t)sq * SEQ;
                att::attn_unit(R1 + (r0 + qb * 256) * 1024 + hh * 128, R2 + (r0 + qb * 256) * 512 + hh * 64, R3 + r0 * 1024 + hh * 128, KR + r0 * 64, R5 + r0 * 1024 + hh * 128,
                               R1 + (r0 + qb * 256) * 1024 + hh * 128, (char*)lds); } } SEAM(6);
    PH(7) { { FE1 f{R2, GM}; run_gemm(L, R4, (const bf16*)(ws + WS_WMO), 1024, 1024, G, f); }
            { FPlain f{R5}; run_gemm(L, PB, (const bf16*)(ws + WS_WPLE), 1024, 256, G, f); } } SEAM(7);
    PH(8) { FE2 f{R3, R2, GM}; run_gemm(L, R1, (const bf16*)(ws + WS_WAO), 1024, 1024, G, f); } SEAM(8);
    PH(9) { FE3 f{in_ptr(0), in_ptr(1), args.out, R1, SSQ1}; run_gemm(L, R3, (const bf16*)(ws + WS_WOUT), 1024, 1024, G, f); } SEAM(9);
    PH(10) { FF1 f{R2, SSQ1}; run_gemm(L, R1, (const bf16*)(ws + WS_WGU), NGU, 1024, G, f); } SEAM(10);
    PH(11) { FF2 f{args.out, R1}; run_gemm(L, R2, (const bf16*)(ws + WS_WDN), 1024, DFF, G, f); } SEAM(11);
    PH(12) { FG1 f{args.out, R5}; run_gemm(L, R1, (const bf16*)(ws + WS_WPG), 1024, 1024, G, f); } SEAM(12);
    PH(13) { t4_final(args.out, in_ptr(22), gw, NGW, lane_id()); }
#undef PH
#undef SEAM
}

extern "C" void kernel_launch(void* const* d_in, const int* in_sizes, int n_in, void* d_out, int out_size, void* d_ws, size_t ws_size, hipStream_t stream) {
    static int grid = 0;
    if (grid == 0) {
        if (n_in != 23 || in_sizes[0] != MP * DM || out_size != M * DM || ws_size < WS_END) {
            fprintf(stderr, "kernel_launch: unexpected shapes: n_in %d in0 %d out %d ws %zu (need %zu); nothing launched\n", n_in, n_in > 0 ? in_sizes[0] : -1, out_size, ws_size, (size_t)WS_END); grid = -1; return; }
        int dev = 0, cus = 0, per_cu = 0;
        if (hipGetDevice(&dev) != hipSuccess || hipDeviceGetAttribute(&cus, hipDeviceAttributeMultiprocessorCount, dev) != hipSuccess) { fprintf(stderr, "kernel_launch: device query failed\n"); grid = -1; return; }
        if (hipFuncSetAttribute((const void*)fwd_kernel, hipFuncAttributeMaxDynamicSharedMemorySize, LDS_BYTES) != hipSuccess) { fprintf(stderr, "kernel_launch: hipFuncSetAttribute failed\n"); grid = -1; return; }
        if (hipOccupancyMaxActiveBlocksPerMultiprocessor(&per_cu, (const void*)fwd_kernel, NWAVES * 64, LDS_BYTES) != hipSuccess || per_cu < 1)
            fprintf(stderr, "kernel_launch: note: occupancy query reports %d workgroups per CU\n", per_cu);
        (void)hipGetLastError();
        grid = cus;
    }
    if (grid < 0) return;
    if (hipMemsetAsync((char*)d_ws + WS_CTL, 0, CTL_ZERO_BYTES, stream) != hipSuccess) { fprintf(stderr, "kernel_launch: memset failed\n"); return; }
    Args a{};
    for (int i = 0; i < 23; ++i) a.in[i] = (const float*)d_in[i];
    a.out = (float*)d_out; a.ws = (unsigned char*)d_ws;
    for (int li = 0; li < MK_N_LAUNCHES; ++li) {
        a.ph_lo = (MK_N_LAUNCHES == 1) ? 0 : li; a.ph_hi = (MK_N_LAUNCHES == 1) ? N_PHASES : li + 1;
        hipLaunchKernelGGL(fwd_kernel, dim3(grid), dim3(NWAVES * 64), LDS_BYTES, stream, a);
        const hipError_t le = hipPeekAtLastError();
        if (le != hipSuccess) { fprintf(stderr, "kernel_launch: launch failed: %s\n", hipGetErrorName(le)); break; }
    }
}
```

```cpp
#include <hip/hip_runtime.h>
#include <cstdio>
#include <cstdint>
namespace pg8 {
#define PG8_LAS __attribute__((address_space(3)))
typedef unsigned short bf16_t;
typedef short bf16x8 __attribute__((ext_vector_type(8)));
typedef float f32x4 __attribute__((ext_vector_type(4)));
typedef unsigned u32x4 __attribute__((ext_vector_type(4)));
constexpr int BM = 256, BK = 64, HALF = 128, HTB = HALF * BK * 2  , STAGE_BYTES = 8 * HTB, NXCD = 8, WGM = 8;

__host__ __device__ __forceinline__ int lds_byte(int r, int c) { const int st = (r >> 4) * 2 + (c >> 5), rr = r & 15, cc = c & 31, ob = rr * 64 + cc * 2; return st * 1024 + (ob ^ (((ob >> 9) & 1) << 5)); }
__host__ __device__ __forceinline__ void stage_rc(int b, int& R, int& C) { const int st = b / 1024, sb = b % 1024, swz = sb ^ (((sb >> 9) & 1) << 5); R = (st >> 1) * 16 + swz / 64; C = (st & 1) * 32 + (swz % 64) / 2; }
__host__ __device__ __forceinline__ int perm32(int rho) { const int n = rho >> 4, i = rho & 15; return 8 * (i >> 2) + 4 * n + (i & 3); }

struct Unit { int pm, pn, gi; };
struct Gemm { const bf16_t* A; const bf16_t* Bt; int M, N, K; const bf16_t* A2; const bf16_t* Bt2; };

struct StaticOrder {
    int nM, nN, nwg, G, c, rev; unsigned* dump;
    __host__ __device__ void init(int M, int N, int G_, int c_, int rev_ = 0) { nM = M / BM; nN = N / BM; nwg = nM * nN; G = G_; c = c_; rev = rev_; }
    __host__ __device__ bool next(int i, Unit& u) const {
        const long L = (long)i * G + c; if (L >= nwg) return false;
        int wgid = (int)L; { const int q = nwg / NXCD, r = nwg % NXCD, xcd = wgid % NXCD, off = wgid / NXCD; wgid = (xcd < r ? xcd * (q + 1) : r * (q + 1) + (xcd - r) * q) + off; }
        const int nig = WGM * nN, gid = wgid / nig, fm = gid * WGM, gsz = (nM - fm) < WGM ? (nM - fm) : WGM;
        u.gi = 0; u.pm = fm + ((wgid % nig) % gsz); u.pn = (wgid % nig) / gsz; if (rev == 1) u.pm = nM - 1 - u.pm; if (rev == 2) u.pm &= 7; return true;
    }
    __device__ __forceinline__ void a_ready(const Unit&) const {}
    __device__ __forceinline__ void done(const Unit&) const {}
};
struct PairOrder {
    StaticOrder S; unsigned* dump;
    __host__ __device__ bool next(int i, Unit& u) const { if (!S.next(i >> 1, u)) return false; u.gi = i & 1; return true; }
    __device__ __forceinline__ void a_ready(const Unit&) const {}
    __device__ __forceinline__ void done(const Unit&) const {}
};
typedef float f32x2 __attribute__((ext_vector_type(2)));
typedef __bf16 bf16x2_t __attribute__((ext_vector_type(2)));
__device__ __forceinline__ unsigned cvt_pk_bf16(float lo, float hi) { f32x2 v = {lo, hi}; bf16x2_t b = __builtin_convertvector(v, bf16x2_t); return __builtin_bit_cast(unsigned, b); }
__device__ __forceinline__ u32x4 pk8(f32x4 a, f32x4 b) { u32x4 w; w.x = cvt_pk_bf16(a[0], a[1]); w.y = cvt_pk_bf16(a[2], a[3]); w.z = cvt_pk_bf16(b[0], b[1]); w.w = cvt_pk_bf16(b[2], b[3]); return w; }
struct NoLd {};
template <class F> struct Epi8 {
    static constexpr bool PERM = true, AFTER_DRAIN = false;
    static constexpr int NST = F::NST;
    F f;
    mutable float pre[8]; mutable int last_pm;
#ifdef PROBE_EPI
    bool timed; volatile __attribute__((address_space(3))) unsigned* tacc;
#endif
    __device__ __forceinline__ void operator()(const f32x4 (&acc)[2][2][4][2], const Unit& u, int wr, int wc, int fr, int fq) const {
        const int row0 = u.pm * BM + wr * 64 + fr, col0 = u.pn * BM + wc * 32 + 8 * fq;
#ifdef PROBE_EPI
        const unsigned long long pe_t0 = __builtin_amdgcn_s_memrealtime();
#endif
        if (F::HAS_PRE && u.pm != last_pm) {
#pragma unroll
            for (int i = 0; i < 8; ++i) pre[i] = f.pre(row0 + (i >> 2) * HALF + (i & 3) * 16, u.pn);
            last_pm = u.pm; asm volatile("" ::: "memory");
        }
#pragma unroll
        for (int g = 0; g < 8; g += F::GROUP) {
            typename F::Ld ld[F::GROUP];
#pragma unroll
            for (int i = 0; i < F::GROUP; ++i) ld[i] = f.load(row0 + ((g + i) >> 2) * HALF + ((g + i) & 3) * 16, col0, u.pn);
            asm volatile("" ::: "memory");
#pragma unroll
            for (int i = 0; i < F::GROUP; ++i) { const int ai = (g + i) >> 2, m = (g + i) & 3;
                f(row0 + ai * HALF + m * 16, col0, acc[ai][0][m][0], acc[ai][0][m][1], acc[ai][1][m][0], acc[ai][1][m][1], u.pn, wc, fq, pre[g + i], ld[i]); }
            asm volatile("" ::: "memory");
        }
        f.finish(u.pm, u.pn, wr, wc, fr, fq);
#ifdef PROBE_EPI
        if (timed && blockIdx.x == 0 && threadIdx.x == 0) { *tacc += (unsigned)(__builtin_amdgcn_s_memrealtime() - pe_t0); }
#endif
    }
};


template <class F> struct EpiPair {
    static constexpr bool PERM = true, AFTER_DRAIN = false;
    static constexpr int NST = 0;
    F f;
    __device__ __forceinline__ void operator()(f32x4 (&acc)[2][2][4][2], const Unit& u, int wr, int wc, int fr, int fq) const {
        const int row0 = u.pm * BM + wr * 64 + fr, col0 = u.pn * BM + wc * 32 + 8 * fq;
#pragma unroll
        for (int g = 0; g < 8; g += 4) {
            typename F::Ld ld[4];
#pragma unroll
            for (int i = 0; i < 4; ++i) ld[i] = f.load(row0 + ((g + i) >> 2) * HALF + ((g + i) & 3) * 16, col0, u.gi);
            asm volatile("" ::: "memory");
#pragma unroll
            for (int i = 0; i < 4; ++i) { const int ai = (g + i) >> 2, m = (g + i) & 3;
                f.apply(row0 + ai * HALF + m * 16, col0, acc[ai][0][m][0], acc[ai][0][m][1], acc[ai][1][m][0], acc[ai][1][m][1], u.gi, ld[i]); }
            asm volatile("" ::: "memory");
        }
    }
};
#define PG8_ITER_SP2(WVA) do { \
            PG8_LDB(B0, 0, 0); PG8_LDB(B1, 0, 1); PG8_SCHED; PG8_LDA(At, 0, 0); PG8_STAGE(PG8_SA(1, 1), a1 + hstepA, voffA); \
            WVA; PG8_WAIT_L(0); PG8_BAR; PG8_MMA(0, 0, At, B0); PG8_MMA(0, 1, At, B1); PG8_BAR; PG8_SCHED; \
            PG8_LDA(At, 0, 1); PG8_STAGE(PG8_SB(0, 0), b2, voffB); PG8_STAGE(PG8_SB(0, 1), b2 + hstep, voffB); PG8_STAGE(PG8_SA(0, 0), a2, voffA); \
            WVA; PG8_WAIT_L(0); PG8_BAR; PG8_MMA(1, 0, At, B0); PG8_MMA(1, 1, At, B1); PG8_BAR; PG8_SCHED; \
            PG8_LDB(B0, 1, 0); PG8_LDB(B1, 1, 1); PG8_SCHED; PG8_LDA(At, 1, 0); PG8_STAGE(PG8_SA(0, 1), a2 + hstepA, voffA); \
            PG8_WAIT_V(8); PG8_WAIT_L(0); PG8_BAR; PG8_MMA(0, 0, At, B0); PG8_MMA(0, 1, At, B1); PG8_BAR; PG8_SCHED; \
            PG8_LDA(At, 1, 1); PG8_STAGE(PG8_SB(1, 0), b3, voffB); PG8_STAGE(PG8_SB(1, 1), b3 + hstep, voffB); PG8_STAGE(PG8_SA(1, 0), a3, voffA); \
            PG8_WAIT_V(8); PG8_WAIT_L(0); PG8_BAR; PG8_MMA(1, 0, At, B0); PG8_MMA(1, 1, At, B1); PG8_BAR; PG8_SCHED; \
    } while (0)
template <class Epi, class Sched, bool ALIGN_EPI = false, bool SP2 = false, int PFA = 0, int LPR = 16, bool ATILED = false, bool PAIR = false>
__device__ __forceinline__ void gemm_phase(PG8_LAS unsigned char* lds, const Gemm g, const Sched& S, const Epi& E) {
    const int tid = threadIdx.x, wid = __builtin_amdgcn_readfirstlane(tid >> 6), lane = tid & 63, wr = wid >> 2, wc = wid & 3, fr = lane & 15, fq = lane >> 4;
    const int K = g.K, nt = K / BK;
    unsigned voffA[2], voffB[2];
#pragma unroll
    for (int i = 0; i < 2; ++i) { int R, C; stage_rc(tid * 16 + i * 8192, R, C); const int Rb = Epi::PERM ? ((R & ~31) + perm32(R & 31)) : R;
        voffA[i] = ATILED ? (unsigned)(R * 64 + C) * 2u : (unsigned)(R * K + C) * 2u; voffB[i] = (unsigned)(Rb * K + C) * 2u; }
    const size_t kstep = (size_t)(BK * 2);
    const size_t hstep = (size_t)HALF * K * 2;
    const size_t tstep = 2 * hstep;
    const size_t kstepA = ATILED ? (size_t)32768 : kstep, hstepA = ATILED ? (size_t)16384 : hstep;
    const unsigned ldsw = (unsigned)wid * 1024u;
    const int aoff = lds_byte(wr * 64 + fr, fq * 8), boff = lds_byte(wc * 32 + fr, fq * 8);
#define PG8_SA(b, h) (((b) * 2 + (h)) * HTB)
#define PG8_SB(b, h) ((4 + (b) * 2 + (h)) * HTB)
#define PG8_STAGE(bufoff, gbase, voff) do { _Pragma("unroll") for (int _i = 0; _i < 2; ++_i) \
        __builtin_amdgcn_global_load_lds((const unsigned*)((const char*)(gbase) + (voff)[_i]), (PG8_LAS unsigned*)(lds + (bufoff) + ldsw + _i * 8192), 16, 0, 0); } while (0)
#define PG8_LDA(dst, b, h) do { _Pragma("unroll") for (int m = 0; m < 4; ++m) _Pragma("unroll") for (int k = 0; k < 2; ++k) dst[m][k] = *(const PG8_LAS bf16x8*)(lds + PG8_SA(b, h) + aoff + m * 2048 + k * 1024); } while (0)
#define PG8_LDB(dst, b, h) do { _Pragma("unroll") for (int n = 0; n < 2; ++n) _Pragma("unroll") for (int k = 0; k < 2; ++k) dst[n][k] = *(const PG8_LAS bf16x8*)(lds + PG8_SB(b, h) + boff + n * 2048 + k * 1024); } while (0)
#define PG8_MMA(ai, bj, At, Bt) do { __builtin_amdgcn_s_setprio(1); _Pragma("unroll") for (int m = 0; m < 4; ++m) _Pragma("unroll") for (int n = 0; n < 2; ++n) _Pragma("unroll") for (int k = 0; k < 2; ++k) \
        acc[ai][bj][m][n] = __builtin_amdgcn_mfma_f32_16x16x32_bf16(Bt[n][k], At[m][k], acc[ai][bj][m][n], 0, 0, 0); __builtin_amdgcn_s_setprio(0); } while (0)
#define PG8_WAIT_V(n) asm volatile("s_waitcnt vmcnt(" #n ")" ::: "memory")
#define PG8_WAIT_L(n) asm volatile("s_waitcnt lgkmcnt(" #n ")" ::: "memory")
#define PG8_BAR __builtin_amdgcn_s_barrier()
#define PG8_SCHED __builtin_amdgcn_sched_barrier(0)
    Unit cur, nxt; int ui = 0;
    if (!S.next(0, cur)) return;
    f32x4 acc[2][2][4][2];
#pragma unroll
    for (int a = 0; a < 2; ++a)
#pragma unroll
        for (int b = 0; b < 2; ++b)
#pragma unroll
            for (int m = 0; m < 4; ++m)
#pragma unroll
                for (int n = 0; n < 2; ++n) acc[a][b][m][n] = (f32x4){0.f, 0.f, 0.f, 0.f};
    bf16x8 At[4][2], B0[2][2], B1[2][2];
    const char* cA = (const char*)((PAIR && cur.gi) ? g.A2 : g.A) + (size_t)cur.pm * tstep; const char* cB = (const char*)((PAIR && cur.gi) ? g.Bt2 : g.Bt) + (size_t)cur.pn * tstep;
    S.a_ready(cur);
    if constexpr (SP2) {
        PG8_STAGE(PG8_SB(0, 0), cB, voffB); PG8_STAGE(PG8_SB(0, 1), cB + hstep, voffB); PG8_STAGE(PG8_SA(0, 0), cA, voffA); PG8_STAGE(PG8_SA(0, 1), cA + hstepA, voffA);
        if (wr == 1) PG8_BAR;
        PG8_WAIT_V(2); PG8_BAR;
        PG8_STAGE(PG8_SB(1, 0), cB + kstep, voffB); PG8_STAGE(PG8_SA(1, 0), cA + kstepA, voffA); PG8_STAGE(PG8_SB(1, 1), cB + hstep + kstep, voffB);
        PG8_WAIT_V(6); PG8_BAR;
    } else {
        PG8_STAGE(PG8_SB(0, 0), cB, voffB); PG8_STAGE(PG8_SA(0, 0), cA, voffA); PG8_STAGE(PG8_SB(0, 1), cB + hstep, voffB); PG8_STAGE(PG8_SA(0, 1), cA + hstepA, voffA);
        if (wr == 1) PG8_BAR;
        PG8_WAIT_V(4); PG8_BAR;
        PG8_STAGE(PG8_SB(1, 0), cB + kstep, voffB); PG8_STAGE(PG8_SA(1, 0), cA + kstepA, voffA); PG8_STAGE(PG8_SB(1, 1), cB + hstep + kstep, voffB);
        PG8_WAIT_V(6); PG8_BAR;
    }
    if constexpr (SP2 && Epi::NST > 0) {
        const __attribute__((address_space(1))) unsigned* dz = (const __attribute__((address_space(1))) unsigned*)S.dump + tid;
#pragma unroll
        for (int i = 0; i < Epi::NST; ++i) asm volatile("global_store_dword %0, %1, off" :: "v"(dz), "v"(0u) : "memory");
    }
    for (;;) {
        const bool has_next = S.next(ui + 1, nxt);
        const char* nA = has_next ? (const char*)((PAIR && nxt.gi) ? g.A2 : g.A) + (size_t)nxt.pm * tstep : cA; const char* nB = has_next ? (const char*)((PAIR && nxt.gi) ? g.Bt2 : g.Bt) + (size_t)nxt.pn * tstep : cB;
        if constexpr (SP2 && Epi::NST > 0) {
            const char* a1 = cA + kstepA; const char* a2 = cA + 2 * kstepA; const char* b2 = cB + 2 * kstep; const char* a3 = a2 + kstepA; const char* b3 = b2 + kstep;
            if constexpr (Epi::NST == 16) PG8_ITER_SP2(PG8_WAIT_V(24)); else PG8_ITER_SP2(PG8_WAIT_V(16));
        }
        for (int t = (SP2 && Epi::NST > 0) ? 2 : 0; t < nt; t += 2) {
            const bool last = (t == nt - 2);
            const char* a1 = cA + (size_t)(t + 1) * kstepA;
            const char* a2 = last ? nA : cA + (size_t)(t + 2) * kstepA; const char* b2 = last ? nB : cB + (size_t)(t + 2) * kstep;
            const char* a3 = a2 + kstepA; const char* b3 = b2 + kstep;
            if (last && has_next) S.a_ready(nxt);
            if constexpr (SP2) {
            PG8_ITER_SP2(PG8_WAIT_V(8));
            } else {
            PG8_LDB(B0, 0, 0); PG8_SCHED; PG8_LDA(At, 0, 0); PG8_STAGE(PG8_SA(1, 1), a1 + hstepA, voffA);
            PG8_WAIT_L(8); PG8_BAR; PG8_WAIT_L(0); PG8_MMA(0, 0, At, B0); PG8_BAR; PG8_SCHED;
            PG8_LDB(B1, 0, 1); PG8_STAGE(PG8_SB(0, 0), b2, voffB);
            PG8_BAR; PG8_WAIT_L(0); PG8_MMA(0, 1, At, B1); PG8_BAR;
            PG8_LDA(At, 0, 1); PG8_STAGE(PG8_SA(0, 0), a2, voffA);
            PG8_BAR; PG8_WAIT_L(0); PG8_MMA(1, 0, At, B0); PG8_BAR; PG8_SCHED;
            PG8_STAGE(PG8_SB(0, 1), b2 + hstep, voffB);
            PG8_WAIT_V(6); PG8_BAR; PG8_MMA(1, 1, At, B1); PG8_BAR;
            PG8_LDB(B0, 1, 0); PG8_SCHED; PG8_LDA(At, 1, 0); PG8_STAGE(PG8_SA(0, 1), a2 + hstepA, voffA);
            PG8_WAIT_L(8); PG8_BAR; PG8_WAIT_L(0); PG8_MMA(0, 0, At, B0); PG8_BAR; PG8_SCHED;
            PG8_LDB(B1, 1, 1); PG8_STAGE(PG8_SB(1, 0), b3, voffB);
            PG8_BAR; PG8_WAIT_L(0); PG8_MMA(0, 1, At, B1); PG8_BAR;
            PG8_LDA(At, 1, 1); PG8_STAGE(PG8_SA(1, 0), a3, voffA);
            PG8_BAR; PG8_WAIT_L(0); PG8_MMA(1, 0, At, B0); PG8_BAR; PG8_SCHED;
            PG8_STAGE(PG8_SB(1, 1), b3 + hstep, voffB);
            PG8_WAIT_V(6); PG8_BAR; PG8_MMA(1, 1, At, B1); PG8_BAR;
            }
        }
        if constexpr (ALIGN_EPI) { if (wr == 0) PG8_BAR; }
        unsigned pfd = 0u;
        if constexpr (PFA > 0) {
            if (has_next) { constexpr int nl = 64 * LPR; const char* pb = (const char*)g.A + (size_t)nxt.pm * tstep + (size_t)(64 * (nxt.pn & 3)) * K * 2;
#pragma unroll
                for (int j = 0; j < PFA; ++j) { const int l = tid + 512 * j; if (l < nl) { const int row = l / LPR, cl = l - row * LPR; const char* pa = pb + (size_t)row * (LPR * 128) + cl * 128;
                    asm volatile("global_load_dword %0, %1, off" : "=v"(pfd) : "v"(pa) : "memory"); } } }
        }
        if constexpr (!Epi::AFTER_DRAIN) { E(acc, cur, wr, wc, fr, fq); S.done(cur); }
        if constexpr (PFA > 0) { asm volatile("s_waitcnt vmcnt(0)" : "+v"(pfd) :: "memory"); }
        if (!has_next) break;
        if (!(PAIR && cur.gi == 0)) {
#pragma unroll
        for (int a = 0; a < 2; ++a)
#pragma unroll
            for (int b = 0; b < 2; ++b)
#pragma unroll
                for (int m = 0; m < 4; ++m)
#pragma unroll
                    for (int n = 0; n < 2; ++n) acc[a][b][m][n] = (f32x4){0.f, 0.f, 0.f, 0.f};
        }
        cur = nxt; cA = nA; cB = nB; ++ui;
        if constexpr (ALIGN_EPI) { if (wr == 1) PG8_BAR; }
    }
    PG8_WAIT_V(0);
    if constexpr (!ALIGN_EPI) { if (wr == 0) PG8_BAR; }
    PG8_BAR;
    if constexpr (Epi::AFTER_DRAIN) { E.fused(acc, cur, wr, wc, fr, fq, lds, wid, lane); S.done(cur); }
#undef PG8_SA
#undef PG8_SB
#undef PG8_STAGE
#undef PG8_LDA
#undef PG8_LDB
#undef PG8_MMA
#undef PG8_WAIT_V
#undef PG8_WAIT_L
#undef PG8_BAR
#undef PG8_SCHED
}
}
#define GAS __attribute__((address_space(1)))
#define LAS __attribute__((address_space(3)))
typedef unsigned short bf16;
typedef unsigned v4u __attribute__((ext_vector_type(4)));
typedef float f32x4 __attribute__((ext_vector_type(4)));
typedef short bf16x8 __attribute__((ext_vector_type(8)));
typedef GAS unsigned gu32;
typedef GAS unsigned long long gu64;
#define RLX_AGENT __ATOMIC_RELAXED, __HIP_MEMORY_SCOPE_AGENT
#define LDS_WAIT() asm volatile("s_waitcnt lgkmcnt(0)" ::: "memory")
#define VM_WAIT() asm volatile("s_waitcnt vmcnt(0)" ::: "memory")
__device__ __forceinline__ unsigned long long rt() { return __builtin_amdgcn_s_memrealtime(); }
__device__ __forceinline__ unsigned f2bf(float f) { unsigned u = __builtin_bit_cast(unsigned, f); return (u + 0x7fffu + ((u >> 16) & 1u)) >> 16; }
__device__ __forceinline__ unsigned pk2(float lo, float hi) { return f2bf(lo) | (f2bf(hi) << 16); }

#define XB_TMO      128
#define XB_XCNT(j)  (256  + 64 * (j))
#define XB_XSUB(j)  (1280 + 64 * (j))
#define XB_XGEN(j)  (2304 + 64 * (j))
#define XB_TOP      3328
#define XB_TOPGEN   3392
#define XCD_BAR_WORDS 3456
#define XB_SPIN_CAP (1u << 18)

__device__ __forceinline__ unsigned xb_ld(unsigned* p)              { return __hip_atomic_load(p, __ATOMIC_RELAXED, __HIP_MEMORY_SCOPE_AGENT); }
__device__ __forceinline__ unsigned xb_add(unsigned* p, unsigned v) { return __hip_atomic_fetch_add(p, v, __ATOMIC_RELAXED, __HIP_MEMORY_SCOPE_AGENT); }
__device__ __forceinline__ unsigned xb_xcc_id() { return (unsigned)__builtin_amdgcn_s_getreg((3 << 11) | 20) & 0xFu; }
#define XB_SPIN(cond, bar) do { unsigned _sp = 0; while (cond) { __builtin_amdgcn_s_sleep(1); \
    if ((++_sp & 255u) == 0u) { if (xb_ld(&(bar)[XB_TMO])) break; if (_sp > XB_SPIN_CAP) { atomicAdd(&(bar)[XB_TMO], 1u); break; } } } } while (0)

struct XcdBarrier {
    unsigned* bar; unsigned x;
    volatile LAS unsigned* st;
};

__device__ __forceinline__ XcdBarrier xcd_barrier_post(unsigned* bar, volatile LAS unsigned* st) {
    XcdBarrier b; b.bar = bar; b.x = xb_xcc_id(); b.st = st;
    if (threadIdx.x == 0) (void)xb_add(&bar[XB_XCNT(b.x)], 1u);
    return b;
}
__device__ __forceinline__ void xcd_barrier_complete(unsigned* bar, unsigned x, unsigned& nloc, unsigned& nx) {
    const unsigned G = gridDim.x * gridDim.y * gridDim.z;
    unsigned sum, cnt, mine, sp = 0u;
    for (;;) {
        sum = 0u; cnt = 0u; mine = 0u;
#pragma unroll
        for (unsigned j = 0; j < 16; ++j) { const unsigned c = xb_ld(&bar[XB_XCNT(j)]); sum += c; cnt += (c > 0u) ? 1u : 0u; mine = (j == x) ? c : mine; }
        if (sum == G) break;
        __builtin_amdgcn_s_sleep(1);
        if ((++sp & 255u) == 0u) { if (xb_ld(&bar[XB_TMO])) break; if (sp > XB_SPIN_CAP) { atomicAdd(&bar[XB_TMO], 1u); break; } }
    }
    nloc = mine > 0u ? mine : 1u; nx = cnt > 0u ? cnt : 1u;
}

__device__ __forceinline__ void xcd_barrier(const XcdBarrier& b) {
    asm volatile("s_waitcnt vmcnt(0)" ::: "memory");
    __syncthreads();
    if (threadIdx.x == 0) {
        unsigned* bar = b.bar;
        __builtin_amdgcn_s_waitcnt(0);
        unsigned nloc = b.st[0], nx = b.st[1];
        if (nloc == 0u) { xcd_barrier_complete(bar, b.x, nloc, nx); b.st[0] = nloc; b.st[1] = nx; }
        const unsigned old = xb_add(&bar[XB_XSUB(b.x)], 1u);
        const unsigned gen = old / nloc;
        if (old + 1u == (gen + 1u) * nloc) {
            __builtin_amdgcn_fence(__ATOMIC_RELEASE, "agent");
            asm volatile("s_waitcnt vmcnt(0)" ::: "memory");
            const unsigned og = xb_add(&bar[XB_TOP], 1u);
            const unsigned tg = og / nx;
            if (og + 1u == (tg + 1u) * nx) xb_add(&bar[XB_TOPGEN], 1u);
            else XB_SPIN(xb_ld(&bar[XB_TOPGEN]) == tg, bar);
            __builtin_amdgcn_fence(__ATOMIC_ACQUIRE, "agent");
            xb_add(&bar[XB_XGEN(b.x)], 1u);
            asm volatile("s_waitcnt vmcnt(0)" ::: "memory");
        } else {
            XB_SPIN(xb_ld(&bar[XB_XGEN(b.x)]) == gen, bar);
            __builtin_amdgcn_fence(__ATOMIC_ACQUIRE, "agent");
            asm volatile("s_waitcnt vmcnt(0)" ::: "memory");
        }
    }
    __syncthreads();
}

constexpr int DM = 1024, SEQ = 4096, NSEQ = 20, MP = 16 * 4096, M = NSEQ * SEQ;
constexpr int DFF = 2816, NIN = 5888, NGU = 5632;
constexpr float EPS = 1e-6f;
constexpr float L2E = 1.4426950408889634f;
constexpr int NWAVES = 8;

constexpr size_t MiB = 1u << 20;
constexpr size_t WS_CTL = 0, CTL_ZERO_BYTES = 32768;
constexpr size_t WS_TAB = 1 * MiB;
constexpr size_t WS_WIN = 2 * MiB, WS_WMO = 14 * MiB, WS_WUQ = 16 * MiB, WS_WUKV = 17 * MiB, WS_WAO = 18 * MiB, WS_WOUT = 20 * MiB,
                 WS_WGU = 22 * MiB, WS_WDN = 33 * MiB, WS_WPLE = 39 * MiB, WS_WPG = 40 * MiB;
constexpr size_t WS_R1 = 64 * MiB, WS_R2 = 224 * MiB, WS_R3 = 384 * MiB, WS_R4 = 544 * MiB, WS_R5 = 704 * MiB;
constexpr size_t WS_CQ = 864 * MiB, WS_CKV = 904 * MiB, WS_KR = 944 * MiB, WS_G = 954 * MiB, WS_SSQQ = 959 * MiB, WS_SSQKV = 961 * MiB,
                 WS_SSQ1 = 963 * MiB, WS_PB = 968 * MiB, WS_END = 1024 * MiB;
static_assert(WS_WIN + (size_t)NIN * 1024 * 2 <= WS_WMO && WS_WGU + (size_t)NGU * 1024 * 2 <= WS_WDN && WS_WDN + (size_t)1024 * DFF * 2 <= WS_WPLE && WS_WPG + 2 * MiB <= WS_R1, "weight map");
static_assert(WS_R1 + (size_t)M * 1024 * 2 == WS_R2 && WS_R5 + (size_t)M * 1024 * 2 == WS_CQ && WS_PB + (size_t)M * 256 * 2 <= WS_END, "activation map");
static_assert(WS_CQ + (size_t)M * 256 * 2 <= WS_CKV && WS_KR + (size_t)M * 64 * 2 <= WS_G && WS_G + (size_t)M * 16 * 4 <= WS_SSQQ && WS_SSQQ + (size_t)M * 16 <= WS_SSQKV && WS_SSQ1 + (size_t)M * 64 <= WS_PB, "small map");
constexpr int CW_BAR = 4096;
static_assert((CW_BAR + 3456) * 4 <= (int)CTL_ZERO_BYTES, "barrier words inside the zeroed block");
constexpr int RING_BYTES = 131072, PHASE_LDS = 162816, MISC_OFF = PHASE_LDS + 320, LDS_BYTES = 163840;

typedef float f32x16 __attribute__((ext_vector_type(16)));
typedef short s16x4 __attribute__((ext_vector_type(4)));
typedef float f32x2g __attribute__((ext_vector_type(2)));

__device__ __forceinline__ unsigned cvtpk(float lo, float hi) { return pg8::cvt_pk_bf16(lo, hi); }
__device__ __forceinline__ float bflo(unsigned w) { return __uint_as_float(w << 16); }
__device__ __forceinline__ float bfhi(unsigned w) { return __uint_as_float(w & 0xffff0000u); }
__device__ __forceinline__ float fexp(float x) { return __builtin_amdgcn_exp2f(x * L2E); }
__device__ __forceinline__ float fsigmoid(float x) { return __builtin_amdgcn_rcpf(1.f + __builtin_amdgcn_exp2f(-x * L2E)); }
__device__ __forceinline__ f32x4 sig4(f32x4 v) { return (f32x4){fsigmoid(v[0]), fsigmoid(v[1]), fsigmoid(v[2]), fsigmoid(v[3])}; }
__device__ __forceinline__ v4u pk8g(f32x4 a, f32x4 b) { v4u w; w.x = cvtpk(a[0], a[1]); w.y = cvtpk(a[2], a[3]); w.z = cvtpk(b[0], b[1]); w.w = cvtpk(b[2], b[3]); return w; }
__device__ __forceinline__ void unpk8(v4u w, f32x4& a, f32x4& b) { a = (f32x4){bflo(w.x), bfhi(w.x), bflo(w.y), bfhi(w.y)}; b = (f32x4){bflo(w.z), bfhi(w.z), bflo(w.w), bfhi(w.w)}; }
__device__ __forceinline__ float wave_sum(float v) {
#pragma unroll
    for (int o = 1; o < 64; o <<= 1) v += __shfl_xor(v, o);
    return v;
}
template <int W> __device__ __forceinline__ size_t toff(int row, int col) { return ((size_t)(row >> 8) * (W / 64) + (col >> 6)) * 16384 + (size_t)(((row & 255) << 6) + (col & 63)); }
__device__ __forceinline__ int lane_id() { return (int)__builtin_amdgcn_mbcnt_hi(~0u, __builtin_amdgcn_mbcnt_lo(~0u, 0u)); }
__device__ __forceinline__ int sig16(int n) { return (n & ~12) | ((n & 4) << 1) | ((n & 8) >> 1); }

struct WDesc { const float* W; const float* gain; bf16* WT; int K, Nsrc, mat; };
__device__ __forceinline__ int src_col(int mat, int n) {
    if (mat == 0) {
        if (n < 1024) return sig16(n);
        if (n < 3072) return n;
        if (n < 5120) return 3664 + (n - 3072);
        if (n < 5376) return 3088 + (n - 5120);
        if (n < 5632) return 3344 + (n - 5376);
        const int j = n - 5632; if (j < 64) return 3600 + (j >> 1) + 32 * (j & 1); if (j < 80) return 3072 + (j - 64); return -1;
    }
    if (mat == 2) {
        if (n < 1024) return (n >> 7) * 192 + (n & 127);
        const int mm = n - 1024, hh = mm >> 6, j = mm & 63; return hh * 192 + 128 + (j >> 1) + 32 * (j & 1);
    }
    if (mat == 3) {
        if (n < 1024) return (n >> 7) * 256 + (n & 127);
        const int mm = n - 1024; return (mm >> 7) * 256 + 128 + (mm & 127);
    }
    return n;
}
__device__ __forceinline__ void wt_item(const float* W, const float* gain, bf16* WT, int K, int Nsrc, int Ndst, int mat, const float* Wup, LAS float* scr, int item, int lane) {
    const int nblk = Ndst / 32, kb = item / nblk, nb = item % nblk, k0 = 64 * kb, n0 = 32 * nb;
    int sc; const float* Ws = W;
    if (mat == 6) { const int pn = n0 >> 8, r0 = n0 & 255; if (r0 >= 128) Ws = Wup; sc = 128 * pn + (r0 & 127) + (lane & 31); }
    else sc = src_col(mat, n0 + (lane & 31));
#pragma unroll 8
    for (int i = 0; i < 32; ++i) { const int kk = 2 * i + (lane >> 5); float v = 0.f; if (sc >= 0) v = ((const GAS float*)Ws)[(size_t)(k0 + kk) * Nsrc + sc]; if (gain) v *= ((const GAS float*)gain)[k0 + kk]; scr[kk * 33 + (lane & 31)] = v; }
    LDS_WAIT(); asm volatile("" ::: "memory");
    const int c = lane & 7;
#pragma unroll
    for (int j = 0; j < 4; ++j) { const int n = (lane >> 3) + 8 * j; const LAS float* s = scr + (8 * c) * 33 + n;
        v4u o; o.x = cvtpk(s[0 * 33], s[1 * 33]); o.y = cvtpk(s[2 * 33], s[3 * 33]); o.z = cvtpk(s[4 * 33], s[5 * 33]); o.w = cvtpk(s[6 * 33], s[7 * 33]);
        *(GAS v4u*)(WT + (size_t)(n0 + n) * K + k0 + 8 * c) = o; }
    LDS_WAIT(); asm volatile("" ::: "memory");
}
__device__ __forceinline__ void sincos_d(double r, double& s, double& c) {
    const double r2 = r * r; double ts = 1.0, tc = 1.0, ss = 1.0, cc = 1.0;
#pragma unroll
    for (int k = 1; k <= 13; ++k) { tc *= -r2 / (double)((2 * k - 1) * (2 * k)); ts *= -r2 / (double)((2 * k) * (2 * k + 1)); cc += tc; ss += ts; }
    s = ss * r; c = cc;
}
__device__ __forceinline__ const float* in_ptr(int k);
__device__ __forceinline__ void p0_prologue(unsigned char* ws, LAS unsigned char* lds, int vcu, int G, int wave, int lane, int tid) {
    LAS float* scr = (LAS float*)(lds + wave * 16384);
    const int gw = vcu * NWAVES + wave, NGW = G * NWAVES;
    constexpr int I_IN = 16 * (NIN / 32), I_SQ = 16 * 32, I_UQ = 4 * 48, I_UKV = 4 * 64, I_GU = 16 * (NGU / 32), I_DN = 44 * 32, I_PLE = 4 * 32;
    constexpr int NITEMS = I_IN + I_SQ + I_UQ + I_UKV + I_SQ + I_SQ + I_GU + I_DN + I_PLE + I_SQ;
    for (int it = gw; it < NITEMS; it += NGW) {
        int r = it;
        if (r < I_IN)  { wt_item(in_ptr(5), nullptr, (bf16*)(ws + WS_WIN), 1024, 5712, NIN, 0, nullptr, scr, r, lane); continue; } r -= I_IN;
        if (r < I_SQ)  { wt_item(in_ptr(9), nullptr, (bf16*)(ws + WS_WMO), 1024, 1024, 1024, 1, nullptr, scr, r, lane); continue; } r -= I_SQ;
        if (r < I_UQ)  { wt_item(in_ptr(11), in_ptr(10), (bf16*)(ws + WS_WUQ), 256, 1536, 1536, 2, nullptr, scr, r, lane); continue; } r -= I_UQ;
        if (r < I_UKV) { wt_item(in_ptr(13), in_ptr(12), (bf16*)(ws + WS_WUKV), 256, 2048, 2048, 3, nullptr, scr, r, lane); continue; } r -= I_UKV;
        if (r < I_SQ)  { wt_item(in_ptr(14), nullptr, (bf16*)(ws + WS_WAO), 1024, 1024, 1024, 1, nullptr, scr, r, lane); continue; } r -= I_SQ;
        if (r < I_SQ)  { wt_item(in_ptr(15), nullptr, (bf16*)(ws + WS_WOUT), 1024, 1024, 1024, 1, nullptr, scr, r, lane); continue; } r -= I_SQ;
        if (r < I_GU)  { wt_item(in_ptr(17), in_ptr(16), (bf16*)(ws + WS_WGU), 1024, DFF, NGU, 6, in_ptr(18), scr, r, lane); continue; } r -= I_GU;
        if (r < I_DN)  { wt_item(in_ptr(19), nullptr, (bf16*)(ws + WS_WDN), DFF, 1024, 1024, 1, nullptr, scr, r, lane); continue; } r -= I_DN;
        if (r < I_PLE) { wt_item(in_ptr(20), nullptr, (bf16*)(ws + WS_WPLE), 256, 1024, 1024, 1, nullptr, scr, r, lane); continue; } r -= I_PLE;
        wt_item(in_ptr(21), nullptr, (bf16*)(ws + WS_WPG), 1024, 1024, 1024, 1, nullptr, scr, r, lane);
    }
    {
        const GAS f32x4* gm = (const GAS f32x4*)in_ptr(4) + lane; f32x4 gv[4];
#pragma unroll
        for (int j = 0; j < 4; ++j) gv[j] = gm[64 * j];
        bf16* H = (bf16*)(ws + WS_R1);
        for (int m = gw; m < M; m += 2 * NGW) {
            const int m2 = m + NGW; const bool has2 = m2 < M; const int mb = has2 ? m2 : m;
            const float* xrow = (m < MP) ? in_ptr(0) + (size_t)m * DM : in_ptr(1) + (size_t)(m - MP) * DM;
            const float* xrow2 = (mb < MP) ? in_ptr(0) + (size_t)mb * DM : in_ptr(1) + (size_t)(mb - MP) * DM;
            const GAS f32x4* xr = (const GAS f32x4*)xrow + lane; const GAS f32x4* xr2 = (const GAS f32x4*)xrow2 + lane; f32x4 v[4], w[4]; float s = 0.f, s2 = 0.f;
#pragma unroll
            for (int j = 0; j < 4; ++j) { v[j] = xr[64 * j]; w[j] = xr2[64 * j]; }
#pragma unroll
            for (int j = 0; j < 4; ++j) { s += (v[j].x * v[j].x + v[j].y * v[j].y) + (v[j].z * v[j].z + v[j].w * v[j].w); s2 += (w[j].x * w[j].x + w[j].y * w[j].y) + (w[j].z * w[j].z + w[j].w * w[j].w); }
            const float rstd = 1.0f / sqrtf(wave_sum(s) * (1.f / DM) + EPS), rstd2 = 1.0f / sqrtf(wave_sum(s2) * (1.f / DM) + EPS);
#pragma unroll
            for (int j = 0; j < 4; ++j) *(GAS unsigned long long*)(H + toff<1024>(m, 4 * lane + 256 * j)) = (unsigned long long)cvtpk(v[j].x * rstd * gv[j].x, v[j].y * rstd * gv[j].y) | ((unsigned long long)cvtpk(v[j].z * rstd * gv[j].z, v[j].w * rstd * gv[j].w) << 32);
            if (has2) {
#pragma unroll
                for (int j = 0; j < 4; ++j) *(GAS unsigned long long*)(H + toff<1024>(mb, 4 * lane + 256 * j)) = (unsigned long long)cvtpk(w[j].x * rstd2 * gv[j].x, w[j].y * rstd2 * gv[j].y) | ((unsigned long long)cvtpk(w[j].z * rstd2 * gv[j].z, w[j].w * rstd2 * gv[j].w) << 32); }
        }
    }
    {
        bf16* PB = (bf16*)(ws + WS_PB); const long n8 = (long)M * 256 / 8, np8 = (long)MP * 256 / 8;
        for (long i = (long)gw * 64 + lane; i < n8; i += (long)NGW * 64) {
            const float* src = (i < np8) ? in_ptr(2) + i * 8 : in_ptr(3) + (i - np8) * 8;
            const f32x4 a = *(const GAS f32x4*)src, b = *(const GAS f32x4*)(src + 4);
            *(GAS v4u*)(PB + toff<256>((int)(i >> 5), (int)(i & 31) * 8)) = pk8g(a, b);
        }
    }
    {
        f32x2g* tab = (f32x2g*)(ws + WS_TAB);
        for (int e = gw * 64 + lane; e < SEQ * 32; e += NGW * 64) {
            const int pos = e >> 5, i = e & 31;
            const double invf = exp(-(double)i * (9.210340371976184 / 32.0));
            const double ang = (double)pos * invf;
            const double k = rint(ang * 0.15915494309189535);
            const double r = ang - k * 6.283185307179586;
            double s, c; sincos_d(r, s, c);
            tab[e] = (f32x2g){(float)c, (float)s};
        }
    }
}

__device__ __forceinline__ void t1_conv(const bf16* QKraw, bf16* QKc, const float* conv_w, int gw, int NGW, int lane) {
    constexpr int NITEM = (M / 8) * 2;
    for (int hf = 0; hf < 2; ++hf) {
        const int c0 = hf * 512 + lane * 8;
        float w[5][8];
#pragma unroll
        for (int j = 0; j < 5; ++j)
#pragma unroll
            for (int k = 0; k < 8; ++k) w[j][k] = ((const GAS float*)conv_w)[j * 1024 + sig16(c0 + k)];
        const float osc = (hf == 0) ? 0.08838834764831845f : 1.0f;
        for (int it = gw; it < NITEM / 2; it += NGW) {
            const int row0 = it * 8, t0 = row0 & (SEQ - 1);
            v4u raw[12];
#pragma unroll
            for (int j = 0; j < 12; ++j) { const int t = t0 + j - 2; raw[j] = (v4u){0u, 0u, 0u, 0u}; if (t >= 0 && t < SEQ) raw[j] = *(const GAS v4u*)(QKraw + toff<1024>(row0 + j - 2, c0)); }
#pragma unroll
            for (int i = 0; i < 8; ++i) {
                f32x4 oa = (f32x4){0.f, 0.f, 0.f, 0.f}, ob = oa;
#pragma unroll
                for (int j = 0; j < 5; ++j) { f32x4 xa, xb; unpk8(raw[i + j], xa, xb);
#pragma unroll
                    for (int k = 0; k < 4; ++k) { oa[k] += xa[k] * w[j][k]; ob[k] += xb[k] * w[j][4 + k]; } }
#pragma unroll
                for (int k = 0; k < 4; ++k) { oa[k] = oa[k] * fsigmoid(oa[k]) * osc; ob[k] = ob[k] * fsigmoid(ob[k]) * osc; }
                *(GAS v4u*)(QKc + (size_t)(row0 + i) * 1024 + c0) = pk8g(oa, ob);
            }
        }
    }
}

__device__ __forceinline__ void t2_combine(const bf16* HMf, const bf16* HMb, bf16* OA, const float* g_mhead, int gw, int NGW, int lane) {
    f32x4 ga[2], gb[2];
#pragma unroll
    for (int i = 0; i < 2; ++i) { ga[i] = *(const GAS f32x4*)(g_mhead + 512 * i + 8 * lane); gb[i] = *(const GAS f32x4*)(g_mhead + 512 * i + 8 * lane + 4); }
    for (int m0 = gw; m0 < M; m0 += 2 * NGW) {
        v4u rf[2][2], rb[2][2], ro[2][2];
#pragma unroll
        for (int q = 0; q < 2; ++q) { const int m = (m0 + q * NGW < M) ? m0 + q * NGW : m0;
#pragma unroll
            for (int i = 0; i < 2; ++i) { const size_t off = (size_t)m * 1024 + 512 * i + 8 * lane;
                rf[q][i] = *(const GAS v4u*)(HMf + off); rb[q][i] = *(const GAS v4u*)(HMb + off); ro[q][i] = *(const GAS v4u*)(OA + toff<1024>(m, 512 * i + 8 * lane)); } }
#pragma unroll
        for (int q = 0; q < 2; ++q) { const int m = m0 + q * NGW; if (m >= M) break;
#pragma unroll
            for (int i = 0; i < 2; ++i) {
                f32x4 fa, fb, ba, bb, oa, ob;
                unpk8(rf[q][i], fa, fb); unpk8(rb[q][i], ba, bb); unpk8(ro[q][i], oa, ob);
                fa += ba; fb += bb;
                float s = (fa[0] * fa[0] + fa[1] * fa[1]) + (fa[2] * fa[2] + fa[3] * fa[3]) + (fb[0] * fb[0] + fb[1] * fb[1]) + (fb[2] * fb[2] + fb[3] * fb[3]);
#pragma unroll
                for (int o = 1; o < 32; o <<= 1) s += __shfl_xor(s, o);
                const float rstd = 1.0f / sqrtf(s * (1.f / 256.f) + EPS);
                fa = fa * rstd * ga[i] * oa; fb = fb * rstd * gb[i] * ob;
                *(GAS v4u*)(OA + toff<1024>(m, 512 * i + 8 * lane)) = pk8g(fa, fb);
            } }
    }
}

__device__ __forceinline__ void t4_final(const bf16* src, float* out, const float* g_final, int gw, int NGW, int lane) {
    f32x4 ga[2], gb[2];
#pragma unroll
    for (int i = 0; i < 2; ++i) { ga[i] = *(const GAS f32x4*)(g_final + 512 * i + 8 * lane); gb[i] = *(const GAS f32x4*)(g_final + 512 * i + 8 * lane + 4); }
    for (int m0 = gw; m0 < M; m0 += 4 * NGW) {
        v4u raw[4][2];
#pragma unroll
        for (int q = 0; q < 4; ++q) { const int m = (m0 + q * NGW < M) ? m0 + q * NGW : m0;
#pragma unroll
            for (int i = 0; i < 2; ++i) raw[q][i] = *(const GAS v4u*)(src + toff<1024>(m, 512 * i + 8 * lane)); }
#pragma unroll
        for (int q = 0; q < 4; ++q) { const int m = m0 + q * NGW; if (m >= M) break;
            f32x4 xa[2], xb[2]; float s = 0.f;
#pragma unroll
            for (int i = 0; i < 2; ++i) { unpk8(raw[q][i], xa[i], xb[i]); s += (xa[i][0] * xa[i][0] + xa[i][1] * xa[i][1]) + (xa[i][2] * xa[i][2] + xa[i][3] * xa[i][3]) + (xb[i][0] * xb[i][0] + xb[i][1] * xb[i][1]) + (xb[i][2] * xb[i][2] + xb[i][3] * xb[i][3]); }
            const float rstd = 1.0f / sqrtf(wave_sum(s) * (1.f / DM) + EPS);
#pragma unroll
            for (int i = 0; i < 2; ++i) { float* o = out + (size_t)m * DM + 512 * i + 8 * lane; *(GAS f32x4*)o = xa[i] * rstd * ga[i]; *(GAS f32x4*)(o + 4) = xb[i] * rstd * gb[i]; }
        }
    }
}

#define KSWZ(row, colB) ((row) * 256 + ((colB) ^ (((row) & 7) << 4)))
#define KRSWZ(row, colB) ((row) * 128 + ((colB) ^ ((((row) >> 1) & 7) << 4)))
#define SBAR() __builtin_amdgcn_sched_barrier(0)
__device__ __forceinline__ int crow(int r, int hi) { return (r & 3) + 8 * (r >> 2) + 4 * hi; }
__device__ __forceinline__ int v_st(int k, int c) { const int kk = (k & ~0xC) | ((k & 4) << 1) | ((k & 8) >> 1); return ((kk >> 3) * 4 + (c >> 5)) * 512 + ((kk & 7) * 32 + (c & 31)) * 2; }
__device__ __forceinline__ int v_rd_base(int lane) { return ((lane & 3) << 3) | (((lane >> 2) & 3) << 6) | (((lane >> 4) & 1) << 5) | (((lane >> 5) & 1) << 8); }
constexpr int v_rd_off(int d0, int ks, int half) { return d0 * 512 + ks * 4096 + half * 2048; }
template <int OFF> __device__ __forceinline__ s16x4 tr_read(int vb) {
    s16x4 r; asm volatile("ds_read_b64_tr_b16 %0, %1 offset:%2" : "=&v"(r) : "v"(vb), "i"(OFF) : "memory"); return r;
}
#define PKF(L, H) (bf16x8){L[0], L[1], L[2], L[3], H[0], H[1], H[2], H[3]}
#define PK4(P, BASE, OUT) do { unsigned a0_ = cvtpk(P[BASE + 0], P[BASE + 1]), a1_ = cvtpk(P[BASE + 2], P[BASE + 3]);   \
    unsigned b0_ = cvtpk(P[BASE + 4], P[BASE + 5]), b1_ = cvtpk(P[BASE + 6], P[BASE + 7]);                              \
    auto r0_ = __builtin_amdgcn_permlane32_swap(a0_, b0_, false, false); auto r1_ = __builtin_amdgcn_permlane32_swap(a1_, b1_, false, false); \
    v4u w_ = {r0_[0], r1_[0], r0_[1], r1_[1]}; OUT = __builtin_bit_cast(bf16x8, w_); } while (0)
__device__ __forceinline__ float swap_add(float x) { auto rr = __builtin_amdgcn_permlane32_swap(__float_as_uint(x), __float_as_uint(x), false, false); return __uint_as_float(rr[0]) + __uint_as_float(rr[1]); }
__device__ __forceinline__ float swap_max(float x) { auto rr = __builtin_amdgcn_permlane32_swap(__float_as_uint(x), __float_as_uint(x), false, false); return fmaxf(__uint_as_float(rr[0]), __uint_as_float(rr[1])); }

namespace att {
constexpr int NW = 8, QBLK = 32, KVBLK = 64;
constexpr float SCALE = 0.07216878364870322f;
constexpr float THR = 8.f;
constexpr int SHM_V = 16384, SHM_K = 16384, SHM_KR = 8192;
constexpr int OFF_V = 0, OFF_K = 3 * SHM_V, OFF_KR = OFF_K + 2 * SHM_K, OFF_WS = OFF_KR + 2 * SHM_KR, OFF_QR = OFF_WS + NW * 64 * 4, ATT_LDS = OFF_QR + NW * 7168;
constexpr int LDQN = 1024, LDQR = 512, LDK = 1024, LDKR = 64, LDO = 1024;

__device__ __forceinline__ void partialSM(f32x16& p0, f32x16& p1, float& m_reg, float& mn, float& alpha) {
    constexpr float C = SCALE * L2E;
    float pmax = p0[0];
#pragma unroll
    for (int r = 1; r < 16; ++r) pmax = fmaxf(pmax, p0[r]);
#pragma unroll
    for (int r = 0; r < 16; ++r) pmax = fmaxf(pmax, p1[r]);
    pmax = swap_max(pmax);
    if (__builtin_expect(__all(pmax - m_reg <= THR / SCALE), 1)) { mn = m_reg; alpha = 1.f; }
    else { mn = fmaxf(m_reg, pmax); alpha = __builtin_amdgcn_exp2f((m_reg - mn) * C); m_reg = mn; }
    const float mnC = -mn * C;
#pragma unroll
    for (int r = 0; r < 16; ++r) p0[r] = fmaf(p0[r], C, mnC);
#pragma unroll
    for (int r = 0; r < 16; ++r) p1[r] = fmaf(p1[r], C, mnC);
#pragma unroll
    for (int r = 0; r < 16; ++r) p0[r] = __builtin_amdgcn_exp2f(p0[r]);
}
__device__ __forceinline__ void finishSM(f32x16& p0, f32x16& p1, float alpha, float& l_reg, bf16x8& pa0, bf16x8& pa1, bf16x8& pa2, bf16x8& pa3) {
#pragma unroll
    for (int r = 0; r < 16; ++r) p1[r] = __builtin_amdgcn_exp2f(p1[r]);
    float ps = 0;
#pragma unroll
    for (int r = 0; r < 16; ++r) ps += p0[r];
#pragma unroll
    for (int r = 0; r < 16; ++r) ps += p1[r];
    ps = swap_add(ps);
    l_reg = l_reg * alpha + ps;
    PK4(p0, 0, pa0); PK4(p0, 8, pa1); PK4(p1, 0, pa2); PK4(p1, 8, pa3);
}
template <int VAR = 0> __device__ __forceinline__ void qkt(f32x16& p0, f32x16& p1, const char* Ks, const char* Krs, const bf16x8* qr, const char* qrl, int r32, int hi) {
#pragma unroll
    for (int r = 0; r < 16; ++r) { p0[r] = 0.f; p1[r] = 0.f; }
#pragma unroll
    for (int d0 = 0; d0 < 8; ++d0) { const int cb = (d0 * 16 + hi * 8) * 2;
        const bf16x8 b0 = *reinterpret_cast<const bf16x8*>(Ks + KSWZ(r32, cb));
        const bf16x8 b1 = *reinterpret_cast<const bf16x8*>(Ks + KSWZ(32 + r32, cb));
        bf16x8 qx; if (d0 < 5 || VAR == 1) qx = qr[d0 % 5]; else qx = *reinterpret_cast<const bf16x8*>(qrl + ((d0 - 5) * 2 + hi) * 512 + r32 * 16);
        p0 = __builtin_amdgcn_mfma_f32_32x32x16_bf16(b0, qx, p0, 0, 0, 0);
        p1 = __builtin_amdgcn_mfma_f32_32x32x16_bf16(b1, qx, p1, 0, 0, 0); }
    if (VAR != 2)
#pragma unroll
    for (int d0 = 0; d0 < 4; ++d0) { const int cb = (d0 * 16 + hi * 8) * 2;
        const bf16x8 b0 = *reinterpret_cast<const bf16x8*>(Krs + KRSWZ(r32, cb));
        const bf16x8 b1 = *reinterpret_cast<const bf16x8*>(Krs + KRSWZ(32 + r32, cb));
        const bf16x8 qx = (VAR == 1) ? qr[d0] : *reinterpret_cast<const bf16x8*>(qrl + 3072 + KRSWZ(r32, cb));
        p0 = __builtin_amdgcn_mfma_f32_32x32x16_bf16(b0, qx, p0, 0, 0, 0);
        p1 = __builtin_amdgcn_mfma_f32_32x32x16_bf16(b1, qx, p1, 0, 0, 0); }
}
template <int D0> __device__ __forceinline__ void pv_one(f32x16& od, int vb, bf16x8 pa0, bf16x8 pa1, bf16x8 pa2, bf16x8 pa3) {
    const s16x4 l0 = tr_read<v_rd_off(D0, 0, 0)>(vb), h0 = tr_read<v_rd_off(D0, 0, 1)>(vb), l1 = tr_read<v_rd_off(D0, 1, 0)>(vb), h1 = tr_read<v_rd_off(D0, 1, 1)>(vb);
    const s16x4 l2 = tr_read<v_rd_off(D0, 2, 0)>(vb), h2 = tr_read<v_rd_off(D0, 2, 1)>(vb), l3 = tr_read<v_rd_off(D0, 3, 0)>(vb), h3 = tr_read<v_rd_off(D0, 3, 1)>(vb);
    asm volatile("s_waitcnt lgkmcnt(0)" ::: "memory"); SBAR();
    od = __builtin_amdgcn_mfma_f32_32x32x16_bf16(pa0, PKF(l0, h0), od, 0, 0, 0);
    od = __builtin_amdgcn_mfma_f32_32x32x16_bf16(pa1, PKF(l1, h1), od, 0, 0, 0);
    od = __builtin_amdgcn_mfma_f32_32x32x16_bf16(pa2, PKF(l2, h2), od, 0, 0, 0);
    od = __builtin_amdgcn_mfma_f32_32x32x16_bf16(pa3, PKF(l3, h3), od, 0, 0, 0);
}
__device__ __forceinline__ void pv_d0(f32x16* o, int vb, bf16x8 pa0, bf16x8 pa1, bf16x8 pa2, bf16x8 pa3) {
    pv_one<0>(o[0], vb, pa0, pa1, pa2, pa3); pv_one<1>(o[1], vb, pa0, pa1, pa2, pa3); pv_one<2>(o[2], vb, pa0, pa1, pa2, pa3); pv_one<3>(o[3], vb, pa0, pa1, pa2, pa3);
}
template <int VAR = 0> __device__ __forceinline__ void attn_unit(const bf16* QnT, const bf16* QrT, const bf16* KnT, const bf16* Kr0, const bf16* VaT, bf16* OT, int r0, int qb, int hh, char* lds) {
    int tid_o = threadIdx.x; asm volatile("" : "+v"(tid_o));
    const int tid = tid_o, wid = tid >> 6, lane = tid & 63, r32 = lane & 31, hi = lane >> 5;
    char* V_lds = lds + OFF_V; char* K_lds = lds + OFF_K; char* KR_lds = lds + OFF_KR;
    float* ws = (float*)(lds + OFF_WS) + wid * 64; float* li_l = ws; float* al_l = ws + 32;
    float m_reg = -1e30f, l_reg = 0; f32x16 o[4]; bf16x8 qr[5]; char* qrl = lds + OFF_QR + wid * 7168;
#pragma unroll
    for (int d = 0; d < 4; ++d)
#pragma unroll
        for (int r = 0; r < 16; ++r) o[d][r] = 0.f;
    const int qrow = r0 + qb * 256 + wid * QBLK + r32;
#pragma unroll
    for (int d0 = 0; d0 < 5; ++d0) qr[d0] = *reinterpret_cast<const bf16x8*>(QnT + toff<1024>(qrow, hh * 128 + d0 * 16 + hi * 8));
#pragma unroll
    for (int d0 = 5; d0 < 8; ++d0) *reinterpret_cast<bf16x8*>(qrl + ((d0 - 5) * 2 + hi) * 512 + r32 * 16) = *reinterpret_cast<const bf16x8*>(QnT + toff<1024>(qrow, hh * 128 + d0 * 16 + hi * 8));
#pragma unroll
    for (int d0 = 0; d0 < 4; ++d0) *reinterpret_cast<bf16x8*>(qrl + 3072 + KRSWZ(r32, (d0 * 16 + hi * 8) * 2)) = *reinterpret_cast<const bf16x8*>(QrT + toff<512>(qrow, hh * 64 + d0 * 16 + hi * 8));
    const int vb0 = (int)(uintptr_t)V_lds + v_rd_base(lane);
    const int wu = __builtin_amdgcn_readfirstlane(wid);
    unsigned kofA, kofR, vofA;
    { const int rowA = 4 * wu + (lane >> 4), cA_ = (lane & 15) ^ (rowA & 7);
      kofA = (unsigned)((cA_ >> 3) * 16384 + rowA * 64 + (cA_ & 7) * 8);
      const int rowR = 8 * wu + (lane >> 3), cR_ = (lane & 7) ^ ((rowR >> 1) & 7); kofR = (unsigned)(rowR * LDKR + cR_ * 8);
      const int subA = 2 * wu + (lane >> 5), kl = (lane & 31) >> 2, cc = (lane & 3) * 8;
      const int kkA = (subA >> 2) * 8 + kl, kA_ = (kkA & ~0xC) | ((kkA & 4) << 1) | ((kkA & 8) >> 1);
      const int vcA = (subA & 3) * 32 + cc;
      vofA = (unsigned)((vcA >> 6) * 16384 + kA_ * 64 + (vcA & 63)); }
#define TDMA(kb, vbuf, k0) do { const size_t tb_ = toff<1024>(r0 + (k0), hh * 128); const bf16* kt_ = KnT + tb_; const bf16* vt_ = VaT + tb_; const bf16* rt_ = Kr0 + (size_t)(r0 + (k0)) * LDKR; \
    __builtin_amdgcn_global_load_lds((const unsigned*)(kt_ + kofA), (LAS unsigned*)(K_lds + (kb) * SHM_K + wu * 1024), 16, 0, 0); \
    __builtin_amdgcn_global_load_lds((const unsigned*)(kt_ + kofA + 2048), (LAS unsigned*)(K_lds + (kb) * SHM_K + 8192 + wu * 1024), 16, 0, 0); \
    __builtin_amdgcn_global_load_lds((const unsigned*)(rt_ + kofR), (LAS unsigned*)(KR_lds + (kb) * SHM_KR + wu * 1024), 16, 0, 0); \
    __builtin_amdgcn_global_load_lds((const unsigned*)(vt_ + vofA), (LAS unsigned*)(V_lds + (vbuf) * SHM_V + wu * 1024), 16, 0, 0); \
    __builtin_amdgcn_global_load_lds((const unsigned*)(vt_ + vofA + 2048), (LAS unsigned*)(V_lds + (vbuf) * SHM_V + 8192 + wu * 1024), 16, 0, 0); } while (0)
#define SWAIT() asm volatile("s_waitcnt vmcnt(0)" ::: "memory")
#define RESC(a) do { if (__any((a) < 1.f)) { if (hi == 0) al_l[r32] = (a); asm volatile("s_waitcnt lgkmcnt(0)" ::: "memory"); \
    _Pragma("unroll") for (int d = 0; d < 4; ++d) _Pragma("unroll") for (int r = 0; r < 16; ++r) o[d][r] *= al_l[crow(r, hi)]; } } while (0)
    f32x16 pA0, pA1, pB0, pB1; float mnA, mnB, alA, alB; bf16x8 pa0, pa1, pa2, pa3; constexpr int NT = SEQ / KVBLK;
    __syncthreads();
    TDMA(0, 0, 0); TDMA(1, 1, KVBLK); SWAIT(); __syncthreads();
    qkt<VAR>(pA0, pA1, K_lds, KR_lds, qr, qrl, r32, hi); partialSM(pA0, pA1, m_reg, mnA, alA);
    __syncthreads();
    int vcur = 0, vnxt = 2;
    for (int j = 1; j + 1 < NT; j += 2) {
        TDMA(0, vnxt, (j + 1) * KVBLK);
        SBAR(); qkt<VAR>(pB0, pB1, K_lds + SHM_K, KR_lds + SHM_KR, qr, qrl, r32, hi);
        finishSM(pA0, pA1, alA, l_reg, pa0, pa1, pa2, pa3); SBAR();
        pv_d0(o, vb0 + vcur * SHM_V, pa0, pa1, pa2, pa3); partialSM(pB0, pB1, m_reg, mnB, alB);
        RESC(alB);
        SWAIT(); __syncthreads();
        vcur = (vcur == 2) ? 0 : vcur + 1; vnxt = (vnxt == 2) ? 0 : vnxt + 1;
        TDMA(1, vnxt, (j + 2) * KVBLK);
        SBAR(); qkt<VAR>(pA0, pA1, K_lds, KR_lds, qr, qrl, r32, hi);
        finishSM(pB0, pB1, alB, l_reg, pa0, pa1, pa2, pa3); SBAR();
        pv_d0(o, vb0 + vcur * SHM_V, pa0, pa1, pa2, pa3); partialSM(pA0, pA1, m_reg, mnA, alA);
        RESC(alA);
        SWAIT(); __syncthreads();
        vcur = (vcur == 2) ? 0 : vcur + 1; vnxt = (vnxt == 2) ? 0 : vnxt + 1;
    }
    SBAR(); qkt<VAR>(pB0, pB1, K_lds + SHM_K, KR_lds + SHM_KR, qr, qrl, r32, hi);
    finishSM(pA0, pA1, alA, l_reg, pa0, pa1, pa2, pa3); SBAR();
    pv_d0(o, vb0 + vcur * SHM_V, pa0, pa1, pa2, pa3); partialSM(pB0, pB1, m_reg, mnB, alB);
    RESC(alB);
    vcur = (vcur == 2) ? 0 : vcur + 1;
    finishSM(pB0, pB1, alB, l_reg, pa0, pa1, pa2, pa3); SBAR();
    pv_d0(o, vb0 + vcur * SHM_V, pa0, pa1, pa2, pa3);
    if (hi == 0) li_l[r32] = l_reg; asm volatile("s_waitcnt lgkmcnt(0)" ::: "memory");
    {
        int le = lane; asm volatile("" : "+v"(le)); const int r32e = le & 31, hie = le >> 5;
        float rli[16];
#pragma unroll
        for (int r = 0; r < 16; ++r) rli[r] = __builtin_amdgcn_rcpf(li_l[crow(r, hie)]);
        bf16* Ow = OT + toff<1024>(r0 + qb * 256 + __builtin_amdgcn_readfirstlane(wid) * QBLK, hh * 128);
        const unsigned ob = (unsigned)(4 * hie * 64 + r32e);
#pragma unroll
        for (int r = 0; r < 16; ++r) { const unsigned orow = (unsigned)((r & 3) + 8 * (r >> 2));
#pragma unroll
            for (int d0 = 0; d0 < 4; ++d0) Ow[ob + orow * 64 + (d0 >> 1) * 16384 + (d0 & 1) * 32] = (bf16)(cvtpk(o[d0][r] * rli[r], 0.f) & 0xffffu); }
    }
#undef TDMA
#undef SWAIT
#undef RESC
}
}

namespace ml {
constexpr int QIMG = 0, KIMG = 16384, KAIMG = 32768, VIMG = 49152, NIMG = 81920, PIMG = 98304, RAOFF = 106496, WSCR = 107520, ML_LDS = WSCR + 8 * 1024;
typedef float f32x4m __attribute__((ext_vector_type(4)));
template <int CTRL, int ROWMASK> __device__ __forceinline__ float dpp_f(float ident, float v) {
    return __builtin_bit_cast(float, __builtin_amdgcn_update_dpp(__builtin_bit_cast(int, ident), __builtin_bit_cast(int, v), CTRL, ROWMASK, 0xf, false));
}
__device__ __forceinline__ float scan_add(float x, int) {
    x += dpp_f<0x111, 0xf>(0.f, x); x += dpp_f<0x112, 0xf>(0.f, x); x += dpp_f<0x114, 0xf>(0.f, x); x += dpp_f<0x118, 0xf>(0.f, x);
    x += dpp_f<0x142, 0xa>(0.f, x); x += dpp_f<0x143, 0xc>(0.f, x);
    return x;
}
__device__ __forceinline__ float scan_max(float x, int) {
    const float NI = -3.0e38f;
    x = fmaxf(x, dpp_f<0x111, 0xf>(NI, x)); x = fmaxf(x, dpp_f<0x112, 0xf>(NI, x)); x = fmaxf(x, dpp_f<0x114, 0xf>(NI, x)); x = fmaxf(x, dpp_f<0x118, 0xf>(NI, x));
    x = fmaxf(x, dpp_f<0x142, 0xa>(NI, x)); x = fmaxf(x, dpp_f<0x143, 0xc>(NI, x));
    return x;
}
__device__ __forceinline__ bf16x8 pack_step(const f32x16& x, int s) {
    v4u p; p.x = cvtpk(x[8 * s + 0], x[8 * s + 1]); p.y = cvtpk(x[8 * s + 2], x[8 * s + 3]); p.z = cvtpk(x[8 * s + 4], x[8 * s + 5]); p.w = cvtpk(x[8 * s + 6], x[8 * s + 7]);
    return __builtin_bit_cast(bf16x8, p);
}
template <int B> __device__ __forceinline__ void qc_tile(const char* lds, const f32x16 (&C)[4], int r32, int hi, f32x16& o2) {
#pragma unroll
    for (int r = 0; r < 16; ++r) o2[r] = 0.f;
#pragma unroll
    for (int dt = 0; dt < 4; ++dt)
#pragma unroll
        for (int s = 0; s < 2; ++s) { const bf16x8 qf = *reinterpret_cast<const bf16x8*>(lds + QIMG + KSWZ(32 * B + r32, ((2 * dt + s) * 16 + hi * 8) * 2));
            o2 = __builtin_amdgcn_mfma_f32_32x32x16_bf16(qf, pack_step(C[dt], s), o2, 0, 0, 0); if (s == 1 && (dt & 1)) SBAR(); }
}
template <int B> __device__ __forceinline__ void pv_tile(const char* lds, int vbV, int r32, int hi, const f32x16& o2, f32x16& hout) {
    f32x16 o;
#pragma unroll
    for (int r = 0; r < 16; ++r) o[r] = 0.f;
    bf16x8 Vf[4];
    { const s16x4 l0 = tr_read<v_rd_off(0, 0, 0)>(vbV), h0 = tr_read<v_rd_off(0, 0, 1)>(vbV), l1 = tr_read<v_rd_off(0, 1, 0)>(vbV), h1 = tr_read<v_rd_off(0, 1, 1)>(vbV);
      s16x4 l2 = l0, h2 = h0, l3 = l1, h3 = h1;
      if (B == 1) { l2 = tr_read<v_rd_off(0, 2, 0)>(vbV); h2 = tr_read<v_rd_off(0, 2, 1)>(vbV); l3 = tr_read<v_rd_off(0, 3, 0)>(vbV); h3 = tr_read<v_rd_off(0, 3, 1)>(vbV); }
      asm volatile("s_waitcnt lgkmcnt(0)" ::: "memory"); SBAR();
      Vf[0] = PKF(l0, h0); Vf[1] = PKF(l1, h1); Vf[2] = PKF(l2, h2); Vf[3] = PKF(l3, h3); }
#pragma unroll
    for (int ks = 0; ks < (B == 0 ? 2 : 4); ++ks) { const bf16x8 pf = *reinterpret_cast<const bf16x8*>(lds + PIMG + KRSWZ(32 * B + r32, (ks * 16 + hi * 8) * 2));
        o = __builtin_amdgcn_mfma_f32_32x32x16_bf16(pf, Vf[ks], o, 0, 0, 0); }
    const float* RA = reinterpret_cast<const float*>(lds + RAOFF);
#pragma unroll
    for (int g = 0; g < 4; ++g) { const f32x4m ra = *reinterpret_cast<const f32x4m*>(RA + 32 * B + 8 * g + 4 * hi);
#pragma unroll
        for (int i = 0; i < 4; ++i) hout[4 * g + i] = o[4 * g + i] + ra[i] * o2[4 * g + i]; }
}
__device__ __forceinline__ void produce_p(char* lds, int W, int lane, int cur, const float* U, const float* Mx, const float* WI, const float* EN) {
    typedef float f32x4a __attribute__((ext_vector_type(4)));
    const int tl = lane & 15, sq = lane >> 4, t = 16 * W + tl;
    bf16x8 qf[4];
#pragma unroll
    for (int ks = 0; ks < 4; ++ks) qf[ks] = *reinterpret_cast<const bf16x8*>(lds + QIMG + KSWZ(t, (ks * 32 + sq * 8) * 2));
    f32x4a an = {0.f, 0.f, 0.f, 0.f};
#pragma unroll
    for (int ks = 0; ks < 4; ++ks) { const bf16x8 nf = *reinterpret_cast<const bf16x8*>(lds + NIMG + cur * 8192 + KSWZ(tl, (ks * 32 + sq * 8) * 2));
        an = __builtin_amdgcn_mfma_f32_16x16x32_bf16(nf, qf[ks], an, 0, 0, 0); }
    float qn = (sq == 0) ? an[0] : 0.f;
    qn += __shfl_xor(qn, 16); qn += __shfl_xor(qn, 32);
    f32x4a acc[4];
#pragma unroll
    for (int j = 0; j < 4; ++j) { acc[j] = (f32x4a){0.f, 0.f, 0.f, 0.f};
        if (j <= W) {
#pragma unroll
            for (int ks = 0; ks < 4; ++ks) { const bf16x8 kf = *reinterpret_cast<const bf16x8*>(lds + KIMG + KSWZ(16 * j + tl, (ks * 32 + sq * 8) * 2));
                acc[j] = __builtin_amdgcn_mfma_f32_16x16x32_bf16(kf, qf[ks], acc[j], 0, 0, 0); } } }
    const float Mt = Mx[t]; float rs = 0.f;
#pragma unroll
    for (int j = 0; j < 4; ++j) { const f32x4a u4 = *reinterpret_cast<const f32x4a*>(U + 16 * j + 4 * sq);
#pragma unroll
        for (int r = 0; r < 4; ++r) { const int s = 16 * j + 4 * sq + r; float w = __builtin_amdgcn_exp2f((u4[r] - Mt) * L2E); if (s > t) w = 0.f; acc[j][r] *= w; rs += acc[j][r]; } }
    rs += __shfl_xor(rs, 16); rs += __shfl_xor(rs, 32);
    const float wi = WI[t], den = rs + wi * qn, inv = __builtin_amdgcn_rcpf(fmaxf(fabsf(den), EN[t]));
    if (sq == 0) reinterpret_cast<float*>(lds + RAOFF)[t] = wi * inv;
#pragma unroll
    for (int j = 0; j < 4; ++j) { unsigned long long w8 = (unsigned long long)cvtpk(acc[j][0] * inv, acc[j][1] * inv) | ((unsigned long long)cvtpk(acc[j][2] * inv, acc[j][3] * inv) << 32);
        *reinterpret_cast<unsigned long long*>(lds + PIMG + KRSWZ(t, (16 * j + 4 * sq) * 2)) = w8; }
}

__device__ __forceinline__ void mlstm_unit(int seqbase, int dir, int h, const bf16* QKc, const bf16* Vg, const float* Gt, bf16* HM, char* lds) {
    const int tid = threadIdx.x, wid = __builtin_amdgcn_readfirstlane(tid >> 6), lane = tid & 63;
    float* wsp = (float*)(lds + WSCR + wid * 1024);
    float* U = wsp; float* Mx = wsp + 64; float* WI = wsp + 128; float* EN = wsp + 192;
    { const v4u z = {0u, 0u, 0u, 0u}; ((v4u*)(lds + NIMG))[tid] = z; ((v4u*)(lds + NIMG))[tid + 512] = z; }
    f32x16 C[4];
#pragma unroll
    for (int d = 0; d < 4; ++d)
#pragma unroll
        for (int r = 0; r < 16; ++r) C[d][r] = 0.f;
    float nreg = 0.f, m = 0.f;
    v4u sq0, sq1, sk0, sk1, sv0, sv1, sv2, sv3; float gi, gf;
#define ROWOF(c, j) (seqbase + (dir ? (SEQ - 1 - ((c) * 64 + (j))) : ((c) * 64 + (j))))
#define MLOAD(c) do { const long row_ = ROWOF(c, ss); const bf16* qp_ = QKc + row_ * 1024 + h * 128 + 16 * seg; const bf16* vp_ = Vg + toff<1024>((int)row_, h * 256 + 32 * seg); \
    sq0 = *(const GAS v4u*)qp_; sq1 = *(const GAS v4u*)(qp_ + 8); sk0 = *(const GAS v4u*)(qp_ + 512); sk1 = *(const GAS v4u*)(qp_ + 520); \
    sv0 = *(const GAS v4u*)vp_; sv1 = *(const GAS v4u*)(vp_ + 8); sv2 = *(const GAS v4u*)(vp_ + 16); sv3 = *(const GAS v4u*)(vp_ + 24); \
    const float* gp_ = Gt + (long)ROWOF(c, (int)(threadIdx.x & 63)) * 16 + 4 * dir + h; gi = gp_[0]; gf = gp_[8]; } while (0)
    float a, es;
#define SCALARS() do { const float b_ = scan_add(gf, lane), u_ = gi - b_, cm_ = scan_max(u_, lane), Mj_ = fmaxf(m, cm_); \
    const float M63_ = __builtin_bit_cast(float, __builtin_amdgcn_readlane(__builtin_bit_cast(int, Mj_), 63)), bl_ = __builtin_bit_cast(float, __builtin_amdgcn_readlane(__builtin_bit_cast(int, b_), 63)); const float e_ = fexp(u_ - M63_); a = fexp(m - M63_); \
    U[lane] = u_; Mx[lane] = Mj_; WI[lane] = fexp(m - Mj_); EN[lane] = fexp(-(b_ + Mj_)); es = __shfl(e_, 8 * wid + (lane >> 3)); m = bl_ + M63_; } while (0)
    { const int ss = tid >> 3, seg = tid & 7; MLOAD(0); }
    SCALARS();
#ifdef MLPROBE_SEG
#define MLSTAMP(k) do { if (blockIdx.x == 0 && threadIdx.x == 0) { const unsigned now_ = (unsigned)__builtin_amdgcn_s_memrealtime(); if ((k) == MLPROBE_SEG) mlp_t0 = now_; if ((k) == MLPROBE_SEG + 1) *(volatile unsigned*)(lds + 163840 - 64) += now_ - mlp_t0; } } while (0)
    unsigned mlp_t0 = 0; if (threadIdx.x == 0) *(volatile unsigned*)(lds + 163840 - 64) = 0u;
#else
#define MLSTAMP(k) do {} while (0)
#endif
    for (int c = 0; c < SEQ / 64; ++c) {
        int lane_o = lane; asm volatile("" : "+v"(lane_o));
        const int r32 = lane_o & 31, hi = lane_o >> 5, ss = 8 * wid + (lane_o >> 3), seg = lane_o & 7;
        const int vbK = (int)(uintptr_t)(lds + KAIMG) + v_rd_base(lane_o);
        const int vbV = (int)(uintptr_t)(lds + VIMG + (wid >> 2) * 16384) + v_rd_base(lane_o) + (wid & 3) * 512;
        MLSTAMP(0);
        __syncthreads();
        MLSTAMP(1);
        {
            *(v4u*)(lds + QIMG + KSWZ(ss, (16 * seg) * 2)) = sq0; *(v4u*)(lds + QIMG + KSWZ(ss, (16 * seg + 8) * 2)) = sq1;
            *(v4u*)(lds + KIMG + KSWZ(ss, (16 * seg) * 2)) = sk0; *(v4u*)(lds + KIMG + KSWZ(ss, (16 * seg + 8) * 2)) = sk1;
        }
        MLSTAMP(1);
        __syncthreads();
        MLSTAMP(2);
        {
            f32x4 a0, a1, b0, b1; unpk8(sk0, a0, a1); unpk8(sk1, b0, b1);
            a0 *= es; a1 *= es; b0 *= es; b1 *= es;
            *(v4u*)(lds + KAIMG + v_st(ss, 16 * seg)) = pk8g(a0, b0); *(v4u*)(lds + KAIMG + v_st(ss, 16 * seg + 8)) = pk8g(a1, b1);
            char* vi = lds + VIMG + (seg >> 2) * 16384; const int vc = 32 * (seg & 3);
            *(v4u*)(vi + v_st(ss, vc)) = sv0; *(v4u*)(vi + v_st(ss, vc + 8)) = sv1; *(v4u*)(vi + v_st(ss, vc + 16)) = sv2; *(v4u*)(vi + v_st(ss, vc + 24)) = sv3;
        }
        if (c + 1 < SEQ / 64) MLOAD(c + 1);
        const float a_c = a;
        f32x16 o2a, o2b;
        if (wid < 4) produce_p(lds, wid, lane_o, c & 1, U, Mx, WI, EN);
        else { qc_tile<0>(lds, C, r32, hi, o2a); SBAR(); qc_tile<1>(lds, C, r32, hi, o2b); SBAR(); }
        MLSTAMP(3);
        __syncthreads();
        MLSTAMP(4);
        if (wid < 4) { qc_tile<0>(lds, C, r32, hi, o2a); SBAR(); qc_tile<1>(lds, C, r32, hi, o2b); SBAR(); }
        {
            const int rstep = dir ? -1024 : 1024;
            bf16* hp0 = HM + (long)ROWOF(c, 0) * 1024 + h * 256 + 32 * wid;
            int loff = r32 + 4 * hi * rstep;
            asm volatile("" : "+v"(loff));
            f32x16 hv;
            pv_tile<0>(lds, vbV, r32, hi, o2a, hv);
#pragma unroll
            for (int r = 0; r < 16; ++r) (hp0 + ((r & 3) + 8 * (r >> 2)) * rstep)[loff] = (bf16)(cvtpk(hv[r], 0.f) & 0xffffu);
            SBAR();
            pv_tile<1>(lds, vbV, r32, hi, o2b, hv);
#pragma unroll
            for (int r = 0; r < 16; ++r) (hp0 + (32 + (r & 3) + 8 * (r >> 2)) * rstep)[loff] = (bf16)(cvtpk(hv[r], 0.f) & 0xffffu);
            SBAR();
        }
        MLSTAMP(5);
        float nsum = 0.f;
        bf16x8 Vf[4];
        { const s16x4 l0 = tr_read<v_rd_off(0, 0, 0)>(vbV), h0 = tr_read<v_rd_off(0, 0, 1)>(vbV), l1 = tr_read<v_rd_off(0, 1, 0)>(vbV), h1 = tr_read<v_rd_off(0, 1, 1)>(vbV);
          const s16x4 l2 = tr_read<v_rd_off(0, 2, 0)>(vbV), h2 = tr_read<v_rd_off(0, 2, 1)>(vbV), l3 = tr_read<v_rd_off(0, 3, 0)>(vbV), h3 = tr_read<v_rd_off(0, 3, 1)>(vbV);
          asm volatile("s_waitcnt lgkmcnt(0)" ::: "memory"); SBAR();
          Vf[0] = PKF(l0, h0); Vf[1] = PKF(l1, h1); Vf[2] = PKF(l2, h2); Vf[3] = PKF(l3, h3); }
#define CUPD(DT) do { \
        bf16x8 f0_, f1_, f2_, f3_; \
        { const s16x4 l0 = tr_read<v_rd_off(DT, 0, 0)>(vbK), h0 = tr_read<v_rd_off(DT, 0, 1)>(vbK), l1 = tr_read<v_rd_off(DT, 1, 0)>(vbK), h1 = tr_read<v_rd_off(DT, 1, 1)>(vbK); \
          const s16x4 l2 = tr_read<v_rd_off(DT, 2, 0)>(vbK), h2 = tr_read<v_rd_off(DT, 2, 1)>(vbK), l3 = tr_read<v_rd_off(DT, 3, 0)>(vbK), h3 = tr_read<v_rd_off(DT, 3, 1)>(vbK); \
          asm volatile("s_waitcnt lgkmcnt(0)" ::: "memory"); SBAR(); \
          f0_ = PKF(l0, h0); f1_ = PKF(l1, h1); f2_ = PKF(l2, h2); f3_ = PKF(l3, h3); } \
        _Pragma("unroll") for (int r = 0; r < 16; ++r) C[DT][r] *= a_c; \
        C[DT] = __builtin_amdgcn_mfma_f32_32x32x16_bf16(f0_, Vf[0], C[DT], 0, 0, 0); C[DT] = __builtin_amdgcn_mfma_f32_32x32x16_bf16(f1_, Vf[1], C[DT], 0, 0, 0); \
        C[DT] = __builtin_amdgcn_mfma_f32_32x32x16_bf16(f2_, Vf[2], C[DT], 0, 0, 0); C[DT] = __builtin_amdgcn_mfma_f32_32x32x16_bf16(f3_, Vf[3], C[DT], 0, 0, 0); \
        if (wid == 4 + DT) { const v4u q0 = __builtin_bit_cast(v4u, f0_), q1 = __builtin_bit_cast(v4u, f1_), q2 = __builtin_bit_cast(v4u, f2_), q3 = __builtin_bit_cast(v4u, f3_); \
            _Pragma("unroll") for (int i = 0; i < 4; ++i) nsum += (bflo(q0[i]) + bfhi(q0[i])) + (bflo(q1[i]) + bfhi(q1[i])) + (bflo(q2[i]) + bfhi(q2[i])) + (bflo(q3[i]) + bfhi(q3[i])); } \
        } while (0)
        CUPD(0); CUPD(1); CUPD(2); CUPD(3);
        if (wid >= 4) {
            nsum = swap_add(nsum); nreg = a_c * nreg + nsum;
            if (hi == 0) { const int p = sig16(32 * (wid - 4) + r32); *(bf16*)(lds + NIMG + ((c + 1) & 1) * 8192 + KSWZ(0, p * 2)) = (bf16)(cvtpk(nreg, 0.f) & 0xffffu); }
        }
        MLSTAMP(6);
        if (c + 1 < SEQ / 64) SCALARS();
        MLSTAMP(7);
    }
#undef CUPD
#undef MLOAD
#undef SCALARS
#undef ROWOF
}
}
#ifndef ALIGN_EPI_FLAG
#define ALIGN_EPI_FLAG true
#endif
#ifndef SP2_FLAG
#define SP2_FLAG true
#endif

#define EPI_ARGS int row, int col, f32x4 a0, f32x4 a1, f32x4 b0, f32x4 b1, int pn, int wc, int fq, float pre, const Ld& ld
#define NO_LD typedef pg8::NoLd Ld; static constexpr int GROUP = 4; __device__ __forceinline__ Ld load(int, int, int) const { return Ld{}; }
#define NO_PRE static constexpr bool HAS_PRE = false; __device__ __forceinline__ float pre(int, int) const { return 0.f; }
#define NO_FIN __device__ __forceinline__ void finish(int, int, int, int, int, int) const {}
#ifndef USE_RELAX
#define NSTV(n) 0
#else
#define NSTV(n) (n)
#endif
#ifdef NT_STORES
__device__ __forceinline__ void st8(bf16* p, f32x4 a, f32x4 b) { __builtin_nontemporal_store(pk8g(a, b), (GAS v4u*)p); }
#else
__device__ __forceinline__ void st8(bf16* p, f32x4 a, f32x4 b) { *(GAS v4u*)p = pk8g(a, b); }
#endif
__device__ __forceinline__ void ld8(const bf16* p, f32x4& a, f32x4& b) { unpk8(*(const GAS v4u*)p, a, b); }
__device__ __forceinline__ float sq8(f32x4 a, f32x4 b) { return (a[0] * a[0] + a[1] * a[1]) + (a[2] * a[2] + a[3] * a[3]) + (b[0] * b[0] + b[1] * b[1]) + (b[2] * b[2] + b[3] * b[3]); }
__device__ __forceinline__ void rope8(const f32x2g* tab, int pos, int i0, f32x4& a0, f32x4& a1) {
    const f32x4 c01 = *(const GAS f32x4*)(tab + pos * 32 + i0), c23 = *(const GAS f32x4*)(tab + pos * 32 + i0 + 2);
    f32x4 r0, r1;
    r0[0] = a0[0] * c01[0] - a0[1] * c01[1]; r0[1] = a0[0] * c01[1] + a0[1] * c01[0];
    r0[2] = a0[2] * c01[2] - a0[3] * c01[3]; r0[3] = a0[2] * c01[3] + a0[3] * c01[2];
    r1[0] = a1[0] * c23[0] - a1[1] * c23[1]; r1[1] = a1[0] * c23[1] + a1[1] * c23[0];
    r1[2] = a1[2] * c23[2] - a1[3] * c23[3]; r1[3] = a1[2] * c23[3] + a1[3] * c23[2];
    a0 = r0; a1 = r1;
}
__device__ __forceinline__ void rope8v(f32x4 c01, f32x4 c23, f32x4& a0, f32x4& a1) {
    f32x4 r0, r1;
    r0[0] = a0[0] * c01[0] - a0[1] * c01[1]; r0[1] = a0[0] * c01[1] + a0[1] * c01[0];
    r0[2] = a0[2] * c01[2] - a0[3] * c01[3]; r0[3] = a0[2] * c01[3] + a0[3] * c01[2];
    r1[0] = a1[0] * c23[0] - a1[1] * c23[1]; r1[1] = a1[0] * c23[1] + a1[1] * c23[0];
    r1[2] = a1[2] * c23[2] - a1[3] * c23[3]; r1[3] = a1[2] * c23[3] + a1[3] * c23[2];
    a0 = r0; a1 = r1;
}
__device__ __forceinline__ float log_sigmoid(float x) { return fminf(x, 0.f) - logf(1.f + expf(-fabsf(x))); }

struct FIn {
    bf16 *qkraw, *vv, *osig, *gm, *cq, *ckv, *kr; float *gates, *ssqq, *ssqkv; const f32x2g* tab; const float* bgate;
    NO_FIN static constexpr int NST = NSTV(0); static constexpr int FENCE = 2; NO_PRE
    static constexpr int GROUP = 4;
    struct Ld { f32x4 c01, c23; };
    __device__ __forceinline__ Ld load(int row, int col, int pn) const { Ld l; l.c01 = (f32x4){0.f, 0.f, 0.f, 0.f}; l.c23 = l.c01;
        if (pn == 22) { const int j = col - 5632;
            if (j < 64) { const f32x2g* t = tab + (row & (SEQ - 1)) * 32 + (j >> 1); l.c01 = *(const GAS f32x4*)t; l.c23 = *(const GAS f32x4*)(t + 2); }
            else if (j < 80) { l.c01 = *(const GAS f32x4*)(bgate + (j - 64)); l.c23 = *(const GAS f32x4*)(bgate + (j - 64) + 4); } }
        return l; }
    __device__ __forceinline__ void operator()(EPI_ARGS) const {
        if (pn < 8) { bf16* t_ = (pn < 4 ? qkraw : vv); st8(t_ + toff<1024>(row, col & 1023), a0, a1); st8(t_ + toff<1024>(row, (col & 1023) + 128), b0, b1); }
        else if (pn < 12) { st8(osig + toff<1024>(row, col - 2048), sig4(a0), sig4(a1)); st8(osig + toff<1024>(row, col - 2048 + 128), sig4(b0), sig4(b1)); }
        else if (pn < 20) { st8(gm + toff<2048>(row, col - 3072), sig4(a0), sig4(a1)); st8(gm + toff<2048>(row, col - 3072 + 128), sig4(b0), sig4(b1)); }
        else if (pn < 22) { bf16* t_ = (pn == 20 ? cq : ckv); st8(t_ + toff<256>(row, col & 255), a0, a1); st8(t_ + toff<256>(row, (col & 255) + 128), b0, b1);
            float s = sq8(a0, a1) + sq8(b0, b1); s += __shfl_xor(s, 16); s += __shfl_xor(s, 32);
            if (fq == 0) (pn == 20 ? ssqq : ssqkv)[(size_t)row * 4 + wc] = s; }
        else { const int j = col - 5632;
            if (j < 64) { rope8v(ld.c01, ld.c23, a0, a1); st8(kr + (size_t)row * 64 + j, a0, a1); }
            else if (j < 80) { a0 += ld.c01; a1 += ld.c23;
                if (j == 72) {
#pragma unroll
                    for (int k = 0; k < 4; ++k) { a0[k] = log_sigmoid(a0[k]); a1[k] = log_sigmoid(a1[k]); } }
                float* gp = gates + (size_t)row * 16 + (j - 64); *(GAS f32x4*)gp = a0; *(GAS f32x4*)(gp + 4) = a1; }
        }
    }
};
struct FQ {
    bf16 *qn, *qr; const float* ssq; const f32x2g* tab;
    NO_LD NO_FIN static constexpr int NST = NSTV(16); static constexpr int FENCE = 2;
    static constexpr bool HAS_PRE = true; __device__ __forceinline__ float pre(int row, int) const { const f32x4 s4 = *(const GAS f32x4*)(ssq + (size_t)row * 4); return 1.0f / sqrtf(((s4[0] + s4[1]) + (s4[2] + s4[3])) * (1.f / 256.f) + EPS); }
    __device__ __forceinline__ void operator()(EPI_ARGS) const {
        const float rstd = pre;
        a0 *= rstd; a1 *= rstd; b0 *= rstd; b1 *= rstd;
        if (pn < 4) { st8(qn + toff<1024>(row, col), a0, a1); st8(qn + toff<1024>(row, col + 128), b0, b1); }
        else { const int c = col - 1024, i0 = (c & 63) >> 1, pos = row & (SEQ - 1); rope8(tab, pos, i0, a0, a1); rope8(tab, pos, i0, b0, b1);
            st8(qr + toff<512>(row, c), a0, a1); st8(qr + toff<512>(row, c + 128), b0, b1); }
    }
};
struct FKV {
    bf16 *kn, *va; const float* ssq;
    NO_LD NO_FIN static constexpr int NST = NSTV(16); static constexpr int FENCE = 2;
    static constexpr bool HAS_PRE = true; __device__ __forceinline__ float pre(int row, int) const { const f32x4 s4 = *(const GAS f32x4*)(ssq + (size_t)row * 4); return 1.0f / sqrtf(((s4[0] + s4[1]) + (s4[2] + s4[3])) * (1.f / 256.f) + EPS); }
    __device__ __forceinline__ void operator()(EPI_ARGS) const {
        const float rstd = pre;
        a0 *= rstd; a1 *= rstd; b0 *= rstd; b1 *= rstd;
        bf16* t_ = (pn < 4 ? kn : va); st8(t_ + toff<1024>(row, col & 1023), a0, a1); st8(t_ + toff<1024>(row, (col & 1023) + 128), b0, b1);
    }
};
struct FE1 {
    bf16* t; const bf16* gm;
    NO_FIN static constexpr int NST = NSTV(16); static constexpr int FENCE = 4, GROUP = 4; NO_PRE
    struct Ld { v4u g0, g1; };
    __device__ __forceinline__ Ld load(int row, int col, int) const { Ld l; l.g0 = *(const GAS v4u*)(gm + toff<2048>(row, col)); l.g1 = *(const GAS v4u*)(gm + toff<2048>(row, col + 128)); return l; }
    __device__ __forceinline__ void operator()(EPI_ARGS) const {
        f32x4 g0, g1, g2, g3; unpk8(ld.g0, g0, g1); unpk8(ld.g1, g2, g3);
        st8(t + toff<1024>(row, col), a0 * g0, a1 * g1); st8(t + toff<1024>(row, col + 128), b0 * g2, b1 * g3);
    }
};
struct FPlain { bf16* o;
    NO_LD NO_FIN static constexpr int NST = NSTV(16); static constexpr int FENCE = 2; NO_PRE
    __device__ __forceinline__ void operator()(EPI_ARGS) const { st8(o + toff<1024>(row, col), a0, a1); st8(o + toff<1024>(row, col + 128), b0, b1); }
};
struct FNone { bf16* o;
    NO_LD NO_FIN static constexpr int NST = NSTV(0); static constexpr int FENCE = 2; NO_PRE
    __device__ __forceinline__ void operator()(EPI_ARGS) const { asm volatile("" :: "v"(a0), "v"(a1), "v"(b0), "v"(b1)); }
};
struct FLin { bf16* o;
    NO_LD NO_FIN static constexpr int NST = NSTV(16); static constexpr int FENCE = 2; NO_PRE
    __device__ __forceinline__ void operator()(EPI_ARGS) const { const int lane = lane_id(), wv = (int)(threadIdx.x >> 6);
        bf16* p = o + ((size_t)(row >> 8) * 4 + pn) * 65536 + (size_t)wv * 8192 + (size_t)((row >> 4) & 7) * 1024 + lane * 8; st8(p, a0, a1); st8(p + 512, b0, b1); }
};
struct FE2 {
    bf16* mg; const bf16* t; const bf16* gm;
    NO_FIN static constexpr int NST = NSTV(16); static constexpr int FENCE = 4, GROUP = 4; NO_PRE
    struct Ld { v4u g0, g1, t0, t1; };
    __device__ __forceinline__ Ld load(int row, int col, int) const {
        Ld l; l.g0 = *(const GAS v4u*)(gm + toff<2048>(row, 1024 + col)); l.g1 = *(const GAS v4u*)(gm + toff<2048>(row, 1024 + col + 128)); l.t0 = *(const GAS v4u*)(t + toff<1024>(row, col)); l.t1 = *(const GAS v4u*)(t + toff<1024>(row, col + 128)); return l; }
    __device__ __forceinline__ void operator()(EPI_ARGS) const {
        f32x4 g0, g1, g2, g3, t0, t1, t2, t3; unpk8(ld.g0, g0, g1); unpk8(ld.g1, g2, g3); unpk8(ld.t0, t0, t1); unpk8(ld.t1, t2, t3);
        st8(mg + toff<1024>(row, col), t0 + a0 * g0, t1 + a1 * g1); st8(mg + toff<1024>(row, col + 128), t2 + b0 * g2, t3 + b1 * g3);
    }
};
struct FE12 {
    bf16* mg; const bf16* gm;
    struct Ld { v4u m0, m1, a0, a1; };
    __device__ __forceinline__ Ld load(int row, int col, int gi) const { Ld l; l.m0 = (v4u){0u, 0u, 0u, 0u}; l.m1 = l.m0;
        if (gi == 0) { l.m0 = *(const GAS v4u*)(gm + toff<2048>(row, col)); l.m1 = *(const GAS v4u*)(gm + toff<2048>(row, col + 128)); }
        l.a0 = *(const GAS v4u*)(gm + toff<2048>(row, 1024 + col)); l.a1 = *(const GAS v4u*)(gm + toff<2048>(row, 1024 + col + 128)); return l; }
    __device__ __forceinline__ void apply(int row, int col, f32x4& a0, f32x4& a1, f32x4& b0, f32x4& b1, int gi, const Ld& ld) const {
        f32x4 ga0, ga1, ga2, ga3; unpk8(ld.a0, ga0, ga1); unpk8(ld.a1, ga2, ga3);
#pragma unroll
        for (int k = 0; k < 4; ++k) { ga0[k] = fmaxf(ga0[k], 1e-20f); ga1[k] = fmaxf(ga1[k], 1e-20f); ga2[k] = fmaxf(ga2[k], 1e-20f); ga3[k] = fmaxf(ga3[k], 1e-20f); }
        if (gi == 0) { f32x4 gm0, gm1, gm2, gm3; unpk8(ld.m0, gm0, gm1); unpk8(ld.m1, gm2, gm3);
#pragma unroll
            for (int k = 0; k < 4; ++k) { a0[k] *= gm0[k] * __builtin_amdgcn_rcpf(ga0[k]); a1[k] *= gm1[k] * __builtin_amdgcn_rcpf(ga1[k]); b0[k] *= gm2[k] * __builtin_amdgcn_rcpf(ga2[k]); b1[k] *= gm3[k] * __builtin_amdgcn_rcpf(ga3[k]); } }
        else { st8(mg + toff<1024>(row, col), a0 * ga0, a1 * ga1); st8(mg + toff<1024>(row, col + 128), b0 * ga2, b1 * ga3); }
    }
};
struct FE3 {
    const float *xp, *xs; bf16* xb; float* ssq; LAS float* tab;
    static constexpr int NST = NSTV(16); static constexpr int FENCE = 4, GROUP = 4; NO_PRE
    struct Ld { f32x4 x0, x1, x2, x3; };
    __device__ __forceinline__ Ld load(int row, int col, int) const { const float* xr = (row < MP ? xp + (size_t)row * DM : xs + (size_t)(row - MP) * DM) + col;
        Ld l; l.x0 = *(const GAS f32x4*)xr; l.x1 = *(const GAS f32x4*)(xr + 4); l.x2 = *(const GAS f32x4*)(xr + 128); l.x3 = *(const GAS f32x4*)(xr + 132); return l; }
    __device__ __forceinline__ void operator()(EPI_ARGS) const {
        a0 += ld.x0; a1 += ld.x1; b0 += ld.x2; b1 += ld.x3;
        st8(xb + toff<1024>(row, col), a0, a1); st8(xb + toff<1024>(row, col + 128), b0, b1);
        float s = sq8(a0, a1) + sq8(b0, b1); s += __shfl_xor(s, 16); s += __shfl_xor(s, 32);
        if (fq == 0) tab[(row & 255) * 4 + wc] = s;
    }
    __device__ __forceinline__ void finish(int pm, int pn, int wr, int wc, int fr, int fq) const {
        asm volatile("s_waitcnt lgkmcnt(0)" ::: "memory"); __builtin_amdgcn_s_barrier(); asm volatile("" ::: "memory");
        if (wc == 0) {
#pragma unroll
            for (int h = 0; h < 2; ++h) { const int rl = 128 * h + 64 * wr + 16 * fq + fr; const f32x4 t4 = *(const LAS f32x4*)(tab + rl * 4);
                ssq[(size_t)(pm * 256 + rl) * 4 + pn] = (t4[0] + t4[1]) + (t4[2] + t4[3]); }
        }
        asm volatile("s_waitcnt lgkmcnt(0)" ::: "memory"); __builtin_amdgcn_s_barrier(); asm volatile("" ::: "memory");
    }
};
struct FF1 {
    bf16* gu; const float* ssq;
    NO_LD NO_FIN static constexpr int NST = NSTV(8); static constexpr int FENCE = 2;
    static constexpr bool HAS_PRE = true; __device__ __forceinline__ float pre(int row, int) const { const f32x4 s4 = *(const GAS f32x4*)(ssq + (size_t)row * 4); return 1.0f / sqrtf(((s4[0] + s4[1]) + (s4[2] + s4[3])) * (1.f / DM) + EPS); }
    __device__ __forceinline__ void operator()(EPI_ARGS) const {
        const float rstd = pre;
        f32x4 r0, r1;
#pragma unroll
        for (int k = 0; k < 4; ++k) { const float g0 = a0[k] * rstd, g1 = a1[k] * rstd; r0[k] = g0 * fsigmoid(g0) * (b0[k] * rstd); r1[k] = g1 * fsigmoid(g1) * (b1[k] * rstd); }
        st8(gu + toff<DFF>(row, col - 128 * pn), r0, r1);
    }
};
struct FF2 {
    const bf16* x1; bf16* xb;
    NO_FIN static constexpr int NST = NSTV(16); static constexpr int FENCE = 4, GROUP = 4; NO_PRE
    struct Ld { v4u r0, r1; };
    __device__ __forceinline__ Ld load(int row, int col, int) const { Ld l; l.r0 = *(const GAS v4u*)(x1 + toff<1024>(row, col)); l.r1 = *(const GAS v4u*)(x1 + toff<1024>(row, col + 128)); return l; }
    __device__ __forceinline__ void operator()(EPI_ARGS) const {
        f32x4 r0, r1, r2, r3; unpk8(ld.r0, r0, r1); unpk8(ld.r1, r2, r3);
        st8(xb + toff<1024>(row, col), a0 + r0, a1 + r1); st8(xb + toff<1024>(row, col + 128), b0 + r2, b1 + r3);
    }
};
struct FG1 {
    bf16* out; const bf16* x2; const bf16* y2;
    NO_FIN static constexpr int NST = NSTV(16); static constexpr int FENCE = 4, GROUP = 4; NO_PRE
    struct Ld { v4u y0, y1, r0, r1; };
    __device__ __forceinline__ Ld load(int row, int col, int) const {
        Ld l; l.y0 = *(const GAS v4u*)(y2 + toff<1024>(row, col)); l.y1 = *(const GAS v4u*)(y2 + toff<1024>(row, col + 128)); l.r0 = *(const GAS v4u*)(x2 + toff<1024>(row, col)); l.r1 = *(const GAS v4u*)(x2 + toff<1024>(row, col + 128));
        return l; }
    __device__ __forceinline__ void operator()(EPI_ARGS) const {
        f32x4 y0, y1, y2v, y3, r0, r1, r2, r3; unpk8(ld.y0, y0, y1); unpk8(ld.y1, y2v, y3); unpk8(ld.r0, r0, r1); unpk8(ld.r1, r2, r3);
        st8(out + toff<1024>(row, col), r0 + sig4(a0) * y0, r1 + sig4(a1) * y1); st8(out + toff<1024>(row, col + 128), r2 + sig4(b0) * y2v, r3 + sig4(b1) * y3);
    }
};
template <class F, int PFA = 0, int LPR = 16, bool ATILED = true> __device__ __forceinline__ void run_gemm(LAS unsigned char* lds, unsigned* dumpw, const bf16* A, const bf16* Bt, int N, int K, int G, const F& f, int skew_ticks = 0, bool probe_this = false, int rev = 0) {
    if (skew_ticks) {
        const unsigned long long t0 = __builtin_amdgcn_s_memrealtime(), want = (unsigned long long)(((blockIdx.x >> 3) & 3) * skew_ticks);
        while (__builtin_amdgcn_s_memrealtime() - t0 < want) __builtin_amdgcn_s_sleep(16);
    }
    asm volatile("" : "+s"(K));
    pg8::Gemm g{A, Bt, M, N, K, nullptr, nullptr}; pg8::StaticOrder S; S.init(M, N, G, (int)blockIdx.x, rev); S.dump = dumpw;
#ifdef PROBE_EPI
    pg8::Epi8<F> E{f, {0.f, 0.f, 0.f, 0.f, 0.f, 0.f, 0.f, 0.f}, -1, probe_this, (volatile LAS unsigned*)(lds + MISC_OFF + 64)};
#else
    pg8::Epi8<F> E{f, {0.f, 0.f, 0.f, 0.f, 0.f, 0.f, 0.f, 0.f}, -1};
#endif
    pg8::gemm_phase<pg8::Epi8<F>, pg8::StaticOrder, ALIGN_EPI_FLAG, SP2_FLAG, PFA, LPR, ATILED>(lds, g, S, E);
}

template <class F> __device__ __forceinline__ void run_gemm_pair(LAS unsigned char* lds, unsigned* dumpw, const bf16* A0, const bf16* B0, const bf16* A1, const bf16* B1, int N, int K, int G, const F& f) {
    asm volatile("" : "+s"(K));
    pg8::Gemm g{A0, B0, M, N, K, A1, B1}; pg8::PairOrder S; S.S.init(M, N, G, (int)blockIdx.x, 0); S.dump = dumpw;
    pg8::EpiPair<F> E{f};
    pg8::gemm_phase<pg8::EpiPair<F>, pg8::PairOrder, ALIGN_EPI_FLAG, SP2_FLAG, 0, 16, true, true>(lds, g, S, E);
}

#ifndef MK_N_LAUNCHES
#define MK_N_LAUNCHES 1
#endif
constexpr int N_PHASES = 14;
#define DUMPW ((unsigned*)(ws + WS_CTL + 524288))
#ifdef USE_PFA
#define PF1 1
#define PF2 2
#define PF6 6
#else
#define PF1 0
#define PF2 0
#define PF6 0
#endif
#ifdef TILED_X2
#define TILED_X2_FLAG true
#else
#define TILED_X2_FLAG false
#endif
#ifndef REV_G1
#define REV_G1 0
#endif
#ifndef SKEWBIG
#define SKEWBIG 0
#endif
#ifndef SKEW
#define SKEW 0
#endif
struct Args { const float* in[23]; float* out; unsigned char* ws; int ph_lo, ph_hi; };
__device__ __forceinline__ const float* in_ptr(int k) {
    typedef const float* __attribute__((address_space(4))) const* kaptr_t;
    kaptr_t ka = (kaptr_t)__builtin_amdgcn_kernarg_segment_ptr(); asm volatile("" : "+s"(ka));
    return ka[k];
}
__global__ void __launch_bounds__(NWAVES * 64, 2) fwd_kernel(Args args) {
    extern __shared__ __attribute__((aligned(16))) unsigned char lds[];
    LAS unsigned char* L = (LAS unsigned char*)lds;
    volatile LAS unsigned* MISC = (volatile LAS unsigned*)(L + MISC_OFF);
    const int tid = threadIdx.x, wave = __builtin_amdgcn_readfirstlane(tid >> 6);
    const int G = gridDim.x, bx = blockIdx.x, vcu = (G % 8 == 0) ? (bx % 8) * (G / 8) + bx / 8 : bx;
    const int gw = vcu * NWAVES + wave, NGW = G * NWAVES;
    unsigned char* ws = args.ws;
    for (int u = tid; u < (LDS_BYTES - PHASE_LDS) / 4; u += NWAVES * 64) ((LAS unsigned*)(L + PHASE_LDS))[u] = 0u;
    static_assert(att::ATT_LDS <= PHASE_LDS && ml::ML_LDS <= PHASE_LDS, "phase scratch");
    __syncthreads();
    XcdBarrier bar = xcd_barrier_post((unsigned*)(ws + WS_CTL) + CW_BAR, MISC + 8);
    bf16 *R1 = (bf16*)(ws + WS_R1), *R2 = (bf16*)(ws + WS_R2), *R3 = (bf16*)(ws + WS_R3), *R4 = (bf16*)(ws + WS_R4), *R5 = (bf16*)(ws + WS_R5);
    bf16 *CQ = (bf16*)(ws + WS_CQ), *CKV = (bf16*)(ws + WS_CKV), *KR = (bf16*)(ws + WS_KR), *PB = (bf16*)(ws + WS_PB);
    float *GT = (float*)(ws + WS_G), *SSQQ = (float*)(ws + WS_SSQQ), *SSQKV = (float*)(ws + WS_SSQKV), *SSQ1 = (float*)(ws + WS_SSQ1);
    const f32x2g* TAB = (const f32x2g*)(ws + WS_TAB);
    bf16* GM = (bf16*)args.out;
    const int PH_LO = args.ph_lo, PH_HI = args.ph_hi;
#ifdef ONLY_PHASE
#define PH(k) if ((k) == ONLY_PHASE)
#else
#define PH(k) if (PH_LO <= (k) && (k) < PH_HI)
#endif
#ifdef PROBE_LO
    unsigned long long pt0 = 0, pt1 = 0;
#define SEAM(k) do { if (PH_LO <= (k) && (k) + 1 < PH_HI) xcd_barrier(bar); if ((k) + 1 == PROBE_LO) pt0 = __builtin_amdgcn_s_memrealtime(); if ((k) + 1 == PROBE_HI) pt1 = __builtin_amdgcn_s_memrealtime(); } while (0)
#else
#define SEAM(k) do { if (PH_LO <= (k) && (k) + 1 < PH_HI) xcd_barrier(bar); } while (0)
#endif

    PH(0) { p0_prologue(ws, L, vcu, G, wave, lane_id(), tid); } SEAM(0);
    PH(1) { FIn f{R2, R3, R4, GM, CQ, CKV, KR, GT, SSQQ, SSQKV, TAB, in_ptr(6)}; run_gemm(L, DUMPW, R1, (const bf16*)(ws + WS_WIN), NIN, 1024, G, f, SKEWBIG); } SEAM(1);
    PH(2) { t1_conv(R2, R1, in_ptr(7), gw, NGW, lane_id()); } SEAM(2);
    PH(3) { if (vcu < NSEQ * 8) { const int sq = vcu >> 3, dir = (vcu >> 2) & 1, hh = vcu & 3; ml::mlstm_unit(sq * SEQ, dir, hh, R1, R3, GT, dir ? R5 : R2, (char*)lds); } } SEAM(3);
    PH(4) { t2_combine(R2, R5, R4, in_ptr(8), gw, NGW, lane_id()); } SEAM(4);
    PH(5) { { FQ f{R1, R2, SSQQ, TAB}; run_gemm<FQ, PF1, 4>(L, DUMPW, CQ, (const bf16*)(ws + WS_WUQ), 1536, 256, G, f); }
            { FKV f{R3, R5, SSQKV}; run_gemm<FKV, PF1, 4>(L, DUMPW, CKV, (const bf16*)(ws + WS_WUKV), 2048, 256, G, f); } } SEAM(5);
    PH(6) { for (int g = vcu; g < NSEQ * 8 * 16; g += G) {
                const int bh = g >> 4, qb = g & 15, sq = bh >> 3, hh = bh & 7;
                att::attn_unit(R1, R2, R3, KR, R5, R1, sq * SEQ, qb, hh, (char*)lds); } } SEAM(6);
#ifdef NO_PAIR
    PH(7) { { FE1 f{R2, GM}; run_gemm<FE1, PF2, 16>(L, DUMPW, R4, (const bf16*)(ws + WS_WMO), 1024, 1024, G, f, SKEW); }
#ifdef PROBE_Y2
            pt0 = __builtin_amdgcn_s_memrealtime();
#endif
            { FPlain f{R5}; run_gemm<FPlain, PF1, 4>(L, DUMPW, PB, (const bf16*)(ws + WS_WPLE), 1024, 256, G, f); } } SEAM(7);
#ifdef PROBE_Y2
    pt1 = __builtin_amdgcn_s_memrealtime();
#endif
    PH(8) { FE2 f{R3, R2, GM}; run_gemm<FE2, PF2, 16>(L, DUMPW, R1, (const bf16*)(ws + WS_WAO), 1024, 1024, G, f, SKEW); } SEAM(8);
#else
    PH(7) { { FE12 f{R3, GM}; run_gemm_pair(L, DUMPW, R4, (const bf16*)(ws + WS_WMO), R1, (const bf16*)(ws + WS_WAO), 1024, 1024, G, f); }
            { FPlain f{R5}; run_gemm<FPlain, PF1, 4>(L, DUMPW, PB, (const bf16*)(ws + WS_WPLE), 1024, 256, G, f); } } SEAM(7);
#endif
    PH(9) { FE3 f{in_ptr(0), in_ptr(1), R1, SSQ1, (LAS float*)(L + RING_BYTES)}; run_gemm<FE3, PF2, 16>(L, DUMPW, R3, (const bf16*)(ws + WS_WOUT), 1024, 1024, G, f, SKEW); } SEAM(9);
    PH(10) { FF1 f{R2, SSQ1}; run_gemm(L, DUMPW, R1, (const bf16*)(ws + WS_WGU), NGU, 1024, G, f, SKEWBIG); } SEAM(10);
    PH(11) { FF2 f{R1, (bf16*)args.out}; run_gemm<FF2, PF6, 44>(L, DUMPW, R2, (const bf16*)(ws + WS_WDN), 1024, DFF, G, f, SKEW); } SEAM(11);
    PH(12) { FG1 f{R2, (const bf16*)args.out, R5}; run_gemm<FG1, PF2, 16>(L, DUMPW, (const bf16*)args.out, (const bf16*)(ws + WS_WPG), 1024, 1024, G, f, SKEW, true, REV_G1); } SEAM(12);
#ifdef PROBE_G1_TWICE
    xcd_barrier(bar); pt0 = __builtin_amdgcn_s_memrealtime();
    { FG1 f{R2, (const bf16*)args.out, R5}; run_gemm<FG1, PF2, 16>(L, DUMPW, (const bf16*)args.out, (const bf16*)(ws + WS_WPG), 1024, 1024, G, f, SKEW, false, REV_G1); }
    xcd_barrier(bar); pt1 = __builtin_amdgcn_s_memrealtime();
#endif
    PH(13) { t4_final(R2, args.out, in_ptr(22), gw, NGW, lane_id()); }
#ifdef MLPROBE_SEG
    if (blockIdx.x == 0 && tid == 0) { const unsigned long long span = *(volatile LAS unsigned*)(L + 163840 - 64), t2 = __builtin_amdgcn_s_memrealtime(); while (__builtin_amdgcn_s_memrealtime() - t2 < 9ull * span) __builtin_amdgcn_s_sleep(32); }
#endif
#ifdef PROBE_EPI
    if (blockIdx.x == 0 && tid == 0) { const unsigned long long span = *(volatile LAS unsigned*)(L + MISC_OFF + 64), t2 = __builtin_amdgcn_s_memrealtime(); while (__builtin_amdgcn_s_memrealtime() - t2 < 9ull * span) __builtin_amdgcn_s_sleep(32); }
#endif
#ifdef PROBE_ATT
    xcd_barrier(bar); pt0 = __builtin_amdgcn_s_memrealtime();
    for (int g = vcu; g < NSEQ * 8 * 16; g += G) { const int bh = g >> 4, qb = g & 15, sq = bh >> 3, hh = bh & 7; att::attn_unit<PROBE_ATT>(R1, R2, R3, KR, R5, R1, sq * SEQ, qb, hh, (char*)lds); }
    xcd_barrier(bar); pt1 = __builtin_amdgcn_s_memrealtime();
#endif
#ifdef PROBE_DUMMY
    xcd_barrier(bar); pt0 = __builtin_amdgcn_s_memrealtime();
#ifdef PROBE_K2816
    { FPlain f{R4}; run_gemm<FPlain, 0, 44>(L, DUMPW, R2, (const bf16*)(ws + WS_WDN), 1024, DFF, G, f, 0, false, PROBE_DUMMY); }
#elif defined(PROBE_LINSTORE)
    { FLin f{R4}; run_gemm<FLin, 0, 16>(L, DUMPW, R1, (const bf16*)(ws + WS_WPG), 1024, 1024, G, f, 0, false, PROBE_DUMMY); }
#elif defined(PROBE_NOSTORE)
    { FNone f{R4}; run_gemm<FNone, 0, 16>(L, DUMPW, R1, (const bf16*)(ws + WS_WPG), 1024, 1024, G, f, 0, false, PROBE_DUMMY); }
#else
    { FPlain f{R4}; run_gemm<FPlain, 0, 16>(L, DUMPW, R1, (const bf16*)(ws + WS_WPG), 1024, 1024, G, f, 0, false, PROBE_DUMMY); }
#endif
    xcd_barrier(bar); pt1 = __builtin_amdgcn_s_memrealtime();
#endif
#ifdef PROBE_LO
    if (PROBE_LO == 0) pt0 = 0;
    if (blockIdx.x == 0 && tid == 0) { const unsigned long long span = pt1 - pt0, t2 = __builtin_amdgcn_s_memrealtime(); while (__builtin_amdgcn_s_memrealtime() - t2 < 9ull * span) __builtin_amdgcn_s_sleep(32); }
#endif
#undef PH
#undef SEAM
}

extern "C" void kernel_launch(void* const* d_in, const int* in_sizes, int n_in, void* d_out, int out_size, void* d_ws, size_t ws_size, hipStream_t stream) {
    static int grid = 0;
    if (grid == 0) {
        if (n_in != 23 || in_sizes[0] != MP * DM || out_size != M * DM || ws_size < WS_END) {
            fprintf(stderr, "kernel_launch: unexpected shapes: n_in %d in0 %d out %d ws %zu (need %zu); nothing launched\n", n_in, n_in > 0 ? in_sizes[0] : -1, out_size, ws_size, (size_t)WS_END); grid = -1; return; }
        int dev = 0, cus = 0, per_cu = 0;
        if (hipGetDevice(&dev) != hipSuccess || hipDeviceGetAttribute(&cus, hipDeviceAttributeMultiprocessorCount, dev) != hipSuccess) { fprintf(stderr, "kernel_launch: device query failed\n"); grid = -1; return; }
        if (hipFuncSetAttribute((const void*)fwd_kernel, hipFuncAttributeMaxDynamicSharedMemorySize, LDS_BYTES) != hipSuccess) { fprintf(stderr, "kernel_launch: hipFuncSetAttribute failed\n"); grid = -1; return; }
        if (hipOccupancyMaxActiveBlocksPerMultiprocessor(&per_cu, (const void*)fwd_kernel, NWAVES * 64, LDS_BYTES) != hipSuccess || per_cu < 1)
            fprintf(stderr, "kernel_launch: note: occupancy query reports %d workgroups per CU\n", per_cu);
        (void)hipGetLastError();
        grid = cus;
    }
    if (grid < 0) return;
    if (hipMemsetAsync((char*)d_ws + WS_CTL, 0, CTL_ZERO_BYTES, stream) != hipSuccess) { fprintf(stderr, "kernel_launch: memset failed\n"); return; }
    Args a{};
    for (int i = 0; i < 23; ++i) a.in[i] = (const float*)d_in[i];
    a.out = (float*)d_out; a.ws = (unsigned char*)d_ws;
    for (int li = 0; li < MK_N_LAUNCHES; ++li) {
        a.ph_lo = (MK_N_LAUNCHES == 1) ? 0 : li; a.ph_hi = (MK_N_LAUNCHES == 1) ? N_PHASES : li + 1;
        hipLaunchKernelGGL(fwd_kernel, dim3(grid), dim3(NWAVES * 64), LDS_BYTES, stream, a);
        const hipError_t le = hipPeekAtLastError();
        if (le != hipSuccess) { fprintf(stderr, "kernel_launch: launch failed: %s\n", hipGetErrorName(le)); break; }
    }
}
```

```cpp
#include <hip/hip_runtime.h>
#include <cstdio>
#include <cstdint>
namespace pg8 {
#define PG8_LAS __attribute__((address_space(3)))
typedef unsigned short bf16_t;
typedef short bf16x8 __attribute__((ext_vector_type(8)));
typedef float f32x4 __attribute__((ext_vector_type(4)));
typedef unsigned u32x4 __attribute__((ext_vector_type(4)));
constexpr int BM = 256, BK = 64, HALF = 128, HTB = HALF * BK * 2  , STAGE_BYTES = 8 * HTB, NXCD = 8, WGM = 8;

__host__ __device__ __forceinline__ int lds_byte(int r, int c) { const int st = (r >> 4) * 2 + (c >> 5), rr = r & 15, cc = c & 31, ob = rr * 64 + cc * 2; return st * 1024 + (ob ^ (((ob >> 9) & 1) << 5)); }
__host__ __device__ __forceinline__ void stage_rc(int b, int& R, int& C) { const int st = b / 1024, sb = b % 1024, swz = sb ^ (((sb >> 9) & 1) << 5); R = (st >> 1) * 16 + swz / 64; C = (st & 1) * 32 + (swz % 64) / 2; }
__host__ __device__ __forceinline__ int perm32(int rho) { const int n = rho >> 4, i = rho & 15; return 8 * (i >> 2) + 4 * n + (i & 3); }

struct Unit { int pm, pn, gi; };
struct Gemm { const bf16_t* A; const bf16_t* Bt; int M, N, K; const bf16_t* A2; const bf16_t* Bt2; };

struct StaticOrder {
    int nM, nN, nwg, G, c, rev; unsigned* dump;
    __host__ __device__ void init(int M, int N, int G_, int c_, int rev_ = 0) { nM = M / BM; nN = N / BM; nwg = nM * nN; G = G_; c = c_; rev = rev_; }
    __host__ __device__ bool next(int i, Unit& u) const {
        const long L = (long)i * G + c; if (L >= nwg) return false;
        int wgid = (int)L; { const int q = nwg / NXCD, r = nwg % NXCD, xcd = wgid % NXCD, off = wgid / NXCD; wgid = (xcd < r ? xcd * (q + 1) : r * (q + 1) + (xcd - r) * q) + off; }
        const int nig = WGM * nN, gid = wgid / nig, fm = gid * WGM, gsz = (nM - fm) < WGM ? (nM - fm) : WGM;
        u.gi = 0; u.pm = fm + ((wgid % nig) % gsz); u.pn = (wgid % nig) / gsz; if (rev == 1) u.pm = nM - 1 - u.pm; if (rev == 2) u.pm &= 7; return true;
    }
    __device__ __forceinline__ void a_ready(const Unit&) const {}
    __device__ __forceinline__ void done(const Unit&) const {}
};
struct PairOrder {
    StaticOrder S; unsigned* dump;
    __host__ __device__ bool next(int i, Unit& u) const { if (!S.next(i >> 1, u)) return false; u.gi = i & 1; return true; }
    __device__ __forceinline__ void a_ready(const Unit&) const {}
    __device__ __forceinline__ void done(const Unit&) const {}
};
typedef float f32x2 __attribute__((ext_vector_type(2)));
typedef __bf16 bf16x2_t __attribute__((ext_vector_type(2)));
__device__ __forceinline__ unsigned cvt_pk_bf16(float lo, float hi) { f32x2 v = {lo, hi}; bf16x2_t b = __builtin_convertvector(v, bf16x2_t); return __builtin_bit_cast(unsigned, b); }
__device__ __forceinline__ u32x4 pk8(f32x4 a, f32x4 b) { u32x4 w; w.x = cvt_pk_bf16(a[0], a[1]); w.y = cvt_pk_bf16(a[2], a[3]); w.z = cvt_pk_bf16(b[0], b[1]); w.w = cvt_pk_bf16(b[2], b[3]); return w; }
struct NoLd {};
template <class F> struct Epi8 {
    static constexpr bool PERM = true, AFTER_DRAIN = false;
    static constexpr int NST = F::NST;
    F f;
    mutable float pre[8]; mutable int last_pm;
#ifdef PROBE_EPI
    bool timed; volatile __attribute__((address_space(3))) unsigned* tacc;
#endif
    __device__ __forceinline__ void operator()(const f32x4 (&acc)[2][2][4][2], const Unit& u, int wr, int wc, int fr, int fq) const {
        const int row0 = u.pm * BM + wr * 64 + fr, col0 = u.pn * BM + wc * 32 + 8 * fq;
#ifdef PROBE_EPI
        const unsigned long long pe_t0 = __builtin_amdgcn_s_memrealtime();
#endif
        if (F::HAS_PRE && u.pm != last_pm) {
#pragma unroll
            for (int i = 0; i < 8; ++i) pre[i] = f.pre(row0 + (i >> 2) * HALF + (i & 3) * 16, u.pn);
            last_pm = u.pm; asm volatile("" ::: "memory");
        }
#pragma unroll
        for (int g = 0; g < 8; g += F::GROUP) {
            typename F::Ld ld[F::GROUP];
#pragma unroll
            for (int i = 0; i < F::GROUP; ++i) ld[i] = f.load(row0 + ((g + i) >> 2) * HALF + ((g + i) & 3) * 16, col0, u.pn);
            asm volatile("" ::: "memory");
#pragma unroll
            for (int i = 0; i < F::GROUP; ++i) { const int ai = (g + i) >> 2, m = (g + i) & 3;
                f(row0 + ai * HALF + m * 16, col0, acc[ai][0][m][0], acc[ai][0][m][1], acc[ai][1][m][0], acc[ai][1][m][1], u.pn, wc, fq, pre[g + i], ld[i]); }
            asm volatile("" ::: "memory");
        }
        f.finish(u.pm, u.pn, wr, wc, fr, fq);
#ifdef PROBE_EPI
        if (timed && blockIdx.x == 0 && threadIdx.x == 0) { *tacc += (unsigned)(__builtin_amdgcn_s_memrealtime() - pe_t0); }
#endif
    }
};


template <class F> struct EpiPair {
    static constexpr bool PERM = true, AFTER_DRAIN = false;
    static constexpr int NST = 0;
    F f;
    __device__ __forceinline__ void operator()(f32x4 (&acc)[2][2][4][2], const Unit& u, int wr, int wc, int fr, int fq) const {
        const int row0 = u.pm * BM + wr * 64 + fr, col0 = u.pn * BM + wc * 32 + 8 * fq;
#pragma unroll
        for (int g = 0; g < 8; g += 4) {
            typename F::Ld ld[4];
#pragma unroll
            for (int i = 0; i < 4; ++i) ld[i] = f.load(row0 + ((g + i) >> 2) * HALF + ((g + i) & 3) * 16, col0, u.gi);
            asm volatile("" ::: "memory");
#pragma unroll
            for (int i = 0; i < 4; ++i) { const int ai = (g + i) >> 2, m = (g + i) & 3;
                f.apply(row0 + ai * HALF + m * 16, col0, acc[ai][0][m][0], acc[ai][0][m][1], acc[ai][1][m][0], acc[ai][1][m][1], u.gi, ld[i]); }
            asm volatile("" ::: "memory");
        }
    }
};
#define PG8_ITER_SP2(WVA) do { \
            PG8_LDB(B0, 0, 0); PG8_LDB(B1, 0, 1); PG8_SCHED; PG8_LDA(At, 0, 0); PG8_STAGE(PG8_SA(1, 1), a1 + hstepA, voffA); \
            WVA; PG8_WAIT_L(0); PG8_BAR; PG8_MMA(0, 0, At, B0); PG8_MMA(0, 1, At, B1); PG8_BAR; PG8_SCHED; \
            PG8_LDA(At, 0, 1); PG8_STAGE(PG8_SB(0, 0), b2, voffB); PG8_STAGE(PG8_SB(0, 1), b2 + hstep, voffB); PG8_STAGE(PG8_SA(0, 0), a2, voffA); \
            WVA; PG8_WAIT_L(0); PG8_BAR; PG8_MMA(1, 0, At, B0); PG8_MMA(1, 1, At, B1); PG8_BAR; PG8_SCHED; \
            PG8_LDB(B0, 1, 0); PG8_LDB(B1, 1, 1); PG8_SCHED; PG8_LDA(At, 1, 0); PG8_STAGE(PG8_SA(0, 1), a2 + hstepA, voffA); \
            PG8_WAIT_V(8); PG8_WAIT_L(0); PG8_BAR; PG8_MMA(0, 0, At, B0); PG8_MMA(0, 1, At, B1); PG8_BAR; PG8_SCHED; \
            PG8_LDA(At, 1, 1); PG8_STAGE(PG8_SB(1, 0), b3, voffB); PG8_STAGE(PG8_SB(1, 1), b3 + hstep, voffB); PG8_STAGE(PG8_SA(1, 0), a3, voffA); \
            PG8_WAIT_V(8); PG8_WAIT_L(0); PG8_BAR; PG8_MMA(1, 0, At, B0); PG8_MMA(1, 1, At, B1); PG8_BAR; PG8_SCHED; \
    } while (0)
template <class Epi, class Sched, bool ALIGN_EPI = false, bool SP2 = false, int PFA = 0, int LPR = 16, bool ATILED = false, bool PAIR = false>
__device__ __forceinline__ void gemm_phase(PG8_LAS unsigned char* lds, const Gemm g, const Sched& S, const Epi& E) {
    const int tid = threadIdx.x, wid = __builtin_amdgcn_readfirstlane(tid >> 6), lane = tid & 63, wr = wid >> 2, wc = wid & 3, fr = lane & 15, fq = lane >> 4;
    const int K = g.K, nt = K / BK;
    unsigned voffA[2], voffB[2];
#pragma unroll
    for (int i = 0; i < 2; ++i) { int R, C; stage_rc(tid * 16 + i * 8192, R, C); const int Rb = Epi::PERM ? ((R & ~31) + perm32(R & 31)) : R;
        voffA[i] = ATILED ? (unsigned)(R * 64 + C) * 2u : (unsigned)(R * K + C) * 2u; voffB[i] = (unsigned)(Rb * K + C) * 2u; }
    const size_t kstep = (size_t)(BK * 2);
    const size_t hstep = (size_t)HALF * K * 2;
    const size_t tstep = 2 * hstep;
    const size_t kstepA = ATILED ? (size_t)32768 : kstep, hstepA = ATILED ? (size_t)16384 : hstep;
    const unsigned ldsw = (unsigned)wid * 1024u;
    const int aoff = lds_byte(wr * 64 + fr, fq * 8), boff = lds_byte(wc * 32 + fr, fq * 8);
#define PG8_SA(b, h) (((b) * 2 + (h)) * HTB)
#define PG8_SB(b, h) ((4 + (b) * 2 + (h)) * HTB)
#define PG8_STAGE(bufoff, gbase, voff) do { _Pragma("unroll") for (int _i = 0; _i < 2; ++_i) \
        __builtin_amdgcn_global_load_lds((const unsigned*)((const char*)(gbase) + (voff)[_i]), (PG8_LAS unsigned*)(lds + (bufoff) + ldsw + _i * 8192), 16, 0, 0); } while (0)
#define PG8_LDA(dst, b, h) do { _Pragma("unroll") for (int m = 0; m < 4; ++m) _Pragma("unroll") for (int k = 0; k < 2; ++k) dst[m][k] = *(const PG8_LAS bf16x8*)(lds + PG8_SA(b, h) + aoff + m * 2048 + k * 1024); } while (0)
#define PG8_LDB(dst, b, h) do { _Pragma("unroll") for (int n = 0; n < 2; ++n) _Pragma("unroll") for (int k = 0; k < 2; ++k) dst[n][k] = *(const PG8_LAS bf16x8*)(lds + PG8_SB(b, h) + boff + n * 2048 + k * 1024); } while (0)
#define PG8_MMA(ai, bj, At, Bt) do { __builtin_amdgcn_s_setprio(1); _Pragma("unroll") for (int m = 0; m < 4; ++m) _Pragma("unroll") for (int n = 0; n < 2; ++n) _Pragma("unroll") for (int k = 0; k < 2; ++k) \
        acc[ai][bj][m][n] = __builtin_amdgcn_mfma_f32_16x16x32_bf16(Bt[n][k], At[m][k], acc[ai][bj][m][n], 0, 0, 0); __builtin_amdgcn_s_setprio(0); } while (0)
#define PG8_WAIT_V(n) asm volatile("s_waitcnt vmcnt(" #n ")" ::: "memory")
#define PG8_WAIT_L(n) asm volatile("s_waitcnt lgkmcnt(" #n ")" ::: "memory")
#define PG8_BAR __builtin_amdgcn_s_barrier()
#define PG8_SCHED __builtin_amdgcn_sched_barrier(0)
    Unit cur, nxt; int ui = 0;
    if (!S.next(0, cur)) return;
    f32x4 acc[2][2][4][2];
#pragma unroll
    for (int a = 0; a < 2; ++a)
#pragma unroll
        for (int b = 0; b < 2; ++b)
#pragma unroll
            for (int m = 0; m < 4; ++m)
#pragma unroll
                for (int n = 0; n < 2; ++n) acc[a][b][m][n] = (f32x4){0.f, 0.f, 0.f, 0.f};
    bf16x8 At[4][2], B0[2][2], B1[2][2];
    const char* cA = (const char*)((PAIR && cur.gi) ? g.A2 : g.A) + (size_t)cur.pm * tstep; const char* cB = (const char*)((PAIR && cur.gi) ? g.Bt2 : g.Bt) + (size_t)cur.pn * tstep;
    S.a_ready(cur);
    if constexpr (SP2) {
        PG8_STAGE(PG8_SB(0, 0), cB, voffB); PG8_STAGE(PG8_SB(0, 1), cB + hstep, voffB); PG8_STAGE(PG8_SA(0, 0), cA, voffA); PG8_STAGE(PG8_SA(0, 1), cA + hstepA, voffA);
        if (wr == 1) PG8_BAR;
        PG8_WAIT_V(2); PG8_BAR;
        PG8_STAGE(PG8_SB(1, 0), cB + kstep, voffB); PG8_STAGE(PG8_SA(1, 0), cA + kstepA, voffA); PG8_STAGE(PG8_SB(1, 1), cB + hstep + kstep, voffB);
        PG8_WAIT_V(6); PG8_BAR;
    } else {
        PG8_STAGE(PG8_SB(0, 0), cB, voffB); PG8_STAGE(PG8_SA(0, 0), cA, voffA); PG8_STAGE(PG8_SB(0, 1), cB + hstep, voffB); PG8_STAGE(PG8_SA(0, 1), cA + hstepA, voffA);
        if (wr == 1) PG8_BAR;
        PG8_WAIT_V(4); PG8_BAR;
        PG8_STAGE(PG8_SB(1, 0), cB + kstep, voffB); PG8_STAGE(PG8_SA(1, 0), cA + kstepA, voffA); PG8_STAGE(PG8_SB(1, 1), cB + hstep + kstep, voffB);
        PG8_WAIT_V(6); PG8_BAR;
    }
    if constexpr (SP2 && Epi::NST > 0) {
        const __attribute__((address_space(1))) unsigned* dz = (const __attribute__((address_space(1))) unsigned*)S.dump + tid;
#pragma unroll
        for (int i = 0; i < Epi::NST; ++i) asm volatile("global_store_dword %0, %1, off" :: "v"(dz), "v"(0u) : "memory");
    }
    for (;;) {
        const bool has_next = S.next(ui + 1, nxt);
        const char* nA = has_next ? (const char*)((PAIR && nxt.gi) ? g.A2 : g.A) + (size_t)nxt.pm * tstep : cA; const char* nB = has_next ? (const char*)((PAIR && nxt.gi) ? g.Bt2 : g.Bt) + (size_t)nxt.pn * tstep : cB;
        if constexpr (SP2 && Epi::NST > 0) {
            const char* a1 = cA + kstepA; const char* a2 = cA + 2 * kstepA; const char* b2 = cB + 2 * kstep; const char* a3 = a2 + kstepA; const char* b3 = b2 + kstep;
            if constexpr (Epi::NST == 16) PG8_ITER_SP2(PG8_WAIT_V(24)); else PG8_ITER_SP2(PG8_WAIT_V(16));
        }
        for (int t = (SP2 && Epi::NST > 0) ? 2 : 0; t < nt; t += 2) {
            const bool last = (t == nt - 2);
            const char* a1 = cA + (size_t)(t + 1) * kstepA;
            const char* a2 = last ? nA : cA + (size_t)(t + 2) * kstepA; const char* b2 = last ? nB : cB + (size_t)(t + 2) * kstep;
            const char* a3 = a2 + kstepA; const char* b3 = b2 + kstep;
            if (last && has_next) S.a_ready(nxt);
            if constexpr (SP2) {
            PG8_ITER_SP2(PG8_WAIT_V(8));
            } else {
            PG8_LDB(B0, 0, 0); PG8_SCHED; PG8_LDA(At, 0, 0); PG8_STAGE(PG8_SA(1, 1), a1 + hstepA, voffA);
            PG8_WAIT_L(8); PG8_BAR; PG8_WAIT_L(0); PG8_MMA(0, 0, At, B0); PG8_BAR; PG8_SCHED;
            PG8_LDB(B1, 0, 1); PG8_STAGE(PG8_SB(0, 0), b2, voffB);
            PG8_BAR; PG8_WAIT_L(0); PG8_MMA(0, 1, At, B1); PG8_BAR;
            PG8_LDA(At, 0, 1); PG8_STAGE(PG8_SA(0, 0), a2, voffA);
            PG8_BAR; PG8_WAIT_L(0); PG8_MMA(1, 0, At, B0); PG8_BAR; PG8_SCHED;
            PG8_STAGE(PG8_SB(0, 1), b2 + hstep, voffB);
            PG8_WAIT_V(6); PG8_BAR; PG8_MMA(1, 1, At, B1); PG8_BAR;
            PG8_LDB(B0, 1, 0); PG8_SCHED; PG8_LDA(At, 1, 0); PG8_STAGE(PG8_SA(0, 1), a2 + hstepA, voffA);
            PG8_WAIT_L(8); PG8_BAR; PG8_WAIT_L(0); PG8_MMA(0, 0, At, B0); PG8_BAR; PG8_SCHED;
            PG8_LDB(B1, 1, 1); PG8_STAGE(PG8_SB(1, 0), b3, voffB);
            PG8_BAR; PG8_WAIT_L(0); PG8_MMA(0, 1, At, B1); PG8_BAR;
            PG8_LDA(At, 1, 1); PG8_STAGE(PG8_SA(1, 0), a3, voffA);
            PG8_BAR; PG8_WAIT_L(0); PG8_MMA(1, 0, At, B0); PG8_BAR; PG8_SCHED;
            PG8_STAGE(PG8_SB(1, 1), b3 + hstep, voffB);
            PG8_WAIT_V(6); PG8_BAR; PG8_MMA(1, 1, At, B1); PG8_BAR;
            }
        }
        if constexpr (ALIGN_EPI) { if (wr == 0) PG8_BAR; }
        unsigned pfd = 0u;
        if constexpr (PFA > 0) {
            if (has_next) { constexpr int nl = 64 * LPR; const char* pb = (const char*)g.A + (size_t)nxt.pm * tstep + (size_t)(64 * (nxt.pn & 3)) * K * 2;
#pragma unroll
                for (int j = 0; j < PFA; ++j) { const int l = tid + 512 * j; if (l < nl) { const int row = l / LPR, cl = l - row * LPR; const char* pa = pb + (size_t)row * (LPR * 128) + cl * 128;
                    asm volatile("global_load_dword %0, %1, off" : "=v"(pfd) : "v"(pa) : "memory"); } } }
        }
        if constexpr (!Epi::AFTER_DRAIN) { E(acc, cur, wr, wc, fr, fq); S.done(cur); }
        if constexpr (PFA > 0) { asm volatile("s_waitcnt vmcnt(0)" : "+v"(pfd) :: "memory"); }
        if (!has_next) break;
        if (!(PAIR && cur.gi == 0)) {
#pragma unroll
        for (int a = 0; a < 2; ++a)
#pragma unroll
            for (int b = 0; b < 2; ++b)
#pragma unroll
                for (int m = 0; m < 4; ++m)
#pragma unroll
                    for (int n = 0; n < 2; ++n) acc[a][b][m][n] = (f32x4){0.f, 0.f, 0.f, 0.f};
        }
        cur = nxt; cA = nA; cB = nB; ++ui;
        if constexpr (ALIGN_EPI) { if (wr == 1) PG8_BAR; }
    }
    PG8_WAIT_V(0);
    if constexpr (!ALIGN_EPI) { if (wr == 0) PG8_BAR; }
    PG8_BAR;
    if constexpr (Epi::AFTER_DRAIN) { E.fused(acc, cur, wr, wc, fr, fq, lds, wid, lane); S.done(cur); }
#undef PG8_SA
#undef PG8_SB
#undef PG8_STAGE
#undef PG8_LDA
#undef PG8_LDB
#undef PG8_MMA
#undef PG8_WAIT_V
#undef PG8_WAIT_L
#undef PG8_BAR
#undef PG8_SCHED
}
}
#define GAS __attribute__((address_space(1)))
#define LAS __attribute__((address_space(3)))
typedef unsigned short bf16;
typedef unsigned v4u __attribute__((ext_vector_type(4)));
typedef float f32x4 __attribute__((ext_vector_type(4)));
typedef short bf16x8 __attribute__((ext_vector_type(8)));
typedef GAS unsigned gu32;
typedef GAS unsigned long long gu64;
#define RLX_AGENT __ATOMIC_RELAXED, __HIP_MEMORY_SCOPE_AGENT
#define LDS_WAIT() asm volatile("s_waitcnt lgkmcnt(0)" ::: "memory")
#define VM_WAIT() asm volatile("s_waitcnt vmcnt(0)" ::: "memory")
__device__ __forceinline__ unsigned long long rt() { return __builtin_amdgcn_s_memrealtime(); }
__device__ __forceinline__ unsigned f2bf(float f) { unsigned u = __builtin_bit_cast(unsigned, f); return (u + 0x7fffu + ((u >> 16) & 1u)) >> 16; }
__device__ __forceinline__ unsigned pk2(float lo, float hi) { return f2bf(lo) | (f2bf(hi) << 16); }

#define XB_TMO      128
#define XB_XCNT(j)  (256  + 64 * (j))
#define XB_XSUB(j)  (1280 + 64 * (j))
#define XB_XGEN(j)  (2304 + 64 * (j))
#define XB_TOP      3328
#define XB_TOPGEN   3392
#define XCD_BAR_WORDS 3456
#define XB_SPIN_CAP (1u << 18)

__device__ __forceinline__ unsigned xb_ld(unsigned* p)              { return __hip_atomic_load(p, __ATOMIC_RELAXED, __HIP_MEMORY_SCOPE_AGENT); }
__device__ __forceinline__ unsigned xb_add(unsigned* p, unsigned v) { return __hip_atomic_fetch_add(p, v, __ATOMIC_RELAXED, __HIP_MEMORY_SCOPE_AGENT); }
__device__ __forceinline__ unsigned xb_xcc_id() { return (unsigned)__builtin_amdgcn_s_getreg((3 << 11) | 20) & 0xFu; }
#define XB_SPIN(cond, bar) do { unsigned _sp = 0; while (cond) { __builtin_amdgcn_s_sleep(1); \
    if ((++_sp & 255u) == 0u) { if (xb_ld(&(bar)[XB_TMO])) break; if (_sp > XB_SPIN_CAP) { atomicAdd(&(bar)[XB_TMO], 1u); break; } } } } while (0)

struct XcdBarrier {
    unsigned* bar; unsigned x;
    volatile LAS unsigned* st;
};

__device__ __forceinline__ XcdBarrier xcd_barrier_post(unsigned* bar, volatile LAS unsigned* st) {
    XcdBarrier b; b.bar = bar; b.x = xb_xcc_id(); b.st = st;
    if (threadIdx.x == 0) (void)xb_add(&bar[XB_XCNT(b.x)], 1u);
    return b;
}
__device__ __forceinline__ void xcd_barrier_complete(unsigned* bar, unsigned x, unsigned& nloc, unsigned& nx) {
    const unsigned G = gridDim.x * gridDim.y * gridDim.z;
    unsigned sum, cnt, mine, sp = 0u;
    for (;;) {
        sum = 0u; cnt = 0u; mine = 0u;
#pragma unroll
        for (unsigned j = 0; j < 16; ++j) { const unsigned c = xb_ld(&bar[XB_XCNT(j)]); sum += c; cnt += (c > 0u) ? 1u : 0u; mine = (j == x) ? c : mine; }
        if (sum == G) break;
        __builtin_amdgcn_s_sleep(1);
        if ((++sp & 255u) == 0u) { if (xb_ld(&bar[XB_TMO])) break; if (sp > XB_SPIN_CAP) { atomicAdd(&bar[XB_TMO], 1u); break; } }
    }
    nloc = mine > 0u ? mine : 1u; nx = cnt > 0u ? cnt : 1u;
}

__device__ __forceinline__ void xcd_barrier(const XcdBarrier& b) {
    asm volatile("s_waitcnt vmcnt(0)" ::: "memory");
    __syncthreads();
    if (threadIdx.x == 0) {
        unsigned* bar = b.bar;
        __builtin_amdgcn_s_waitcnt(0);
        unsigned nloc = b.st[0], nx = b.st[1];
        if (nloc == 0u) { xcd_barrier_complete(bar, b.x, nloc, nx); b.st[0] = nloc; b.st[1] = nx; }
        const unsigned old = xb_add(&bar[XB_XSUB(b.x)], 1u);
        const unsigned gen = old / nloc;
        if (old + 1u == (gen + 1u) * nloc) {
            __builtin_amdgcn_fence(__ATOMIC_RELEASE, "agent");
            asm volatile("s_waitcnt vmcnt(0)" ::: "memory");
            const unsigned og = xb_add(&bar[XB_TOP], 1u);
            const unsigned tg = og / nx;
            if (og + 1u == (tg + 1u) * nx) xb_add(&bar[XB_TOPGEN], 1u);
            else XB_SPIN(xb_ld(&bar[XB_TOPGEN]) == tg, bar);
            __builtin_amdgcn_fence(__ATOMIC_ACQUIRE, "agent");
            xb_add(&bar[XB_XGEN(b.x)], 1u);
            asm volatile("s_waitcnt vmcnt(0)" ::: "memory");
        } else {
            XB_SPIN(xb_ld(&bar[XB_XGEN(b.x)]) == gen, bar);
            __builtin_amdgcn_fence(__ATOMIC_ACQUIRE, "agent");
            asm volatile("s_waitcnt vmcnt(0)" ::: "memory");
        }
    }
    __syncthreads();
}

constexpr int DM = 1024, SEQ = 4096, NSEQ = 20, MP = 16 * 4096, M = NSEQ * SEQ;
constexpr int DFF = 2816, NIN = 5888, NGU = 5632;
constexpr float EPS = 1e-6f;
constexpr float L2E = 1.4426950408889634f;
constexpr int NWAVES = 8;

constexpr size_t MiB = 1u << 20;
constexpr size_t WS_CTL = 0, CTL_ZERO_BYTES = 32768;
constexpr size_t WS_TAB = 1 * MiB;
constexpr size_t WS_WIN = 2 * MiB, WS_WMO = 14 * MiB, WS_WUQ = 16 * MiB, WS_WUKV = 17 * MiB, WS_WAO = 18 * MiB, WS_WOUT = 20 * MiB,
                 WS_WGU = 22 * MiB, WS_WDN = 33 * MiB, WS_WPLE = 39 * MiB, WS_WPG = 40 * MiB;
constexpr size_t WS_R1 = 64 * MiB, WS_R2 = 224 * MiB, WS_R3 = 384 * MiB, WS_R4 = 544 * MiB, WS_R5 = 704 * MiB;
constexpr size_t WS_CQ = 864 * MiB, WS_CKV = 904 * MiB, WS_KR = 944 * MiB, WS_G = 954 * MiB, WS_SSQQ = 959 * MiB, WS_SSQKV = 961 * MiB,
                 WS_SSQ1 = 963 * MiB, WS_PB = 968 * MiB, WS_END = 1024 * MiB;
static_assert(WS_WIN + (size_t)NIN * 1024 * 2 <= WS_WMO && WS_WGU + (size_t)NGU * 1024 * 2 <= WS_WDN && WS_WDN + (size_t)1024 * DFF * 2 <= WS_WPLE && WS_WPG + 2 * MiB <= WS_R1, "weight map");
static_assert(WS_R1 + (size_t)M * 1024 * 2 == WS_R2 && WS_R5 + (size_t)M * 1024 * 2 == WS_CQ && WS_PB + (size_t)M * 256 * 2 <= WS_END, "activation map");
static_assert(WS_CQ + (size_t)M * 256 * 2 <= WS_CKV && WS_KR + (size_t)M * 64 * 2 <= WS_G && WS_G + (size_t)M * 16 * 4 <= WS_SSQQ && WS_SSQQ + (size_t)M * 16 <= WS_SSQKV && WS_SSQ1 + (size_t)M * 64 <= WS_PB, "small map");
constexpr int CW_BAR = 4096;
static_assert((CW_BAR + 3456) * 4 <= (int)CTL_ZERO_BYTES, "barrier words inside the zeroed block");
constexpr int RING_BYTES = 131072, PHASE_LDS = 162816, MISC_OFF = PHASE_LDS + 320, LDS_BYTES = 163840;

typedef float f32x16 __attribute__((ext_vector_type(16)));
typedef short s16x4 __attribute__((ext_vector_type(4)));
typedef float f32x2g __attribute__((ext_vector_type(2)));

__device__ __forceinline__ unsigned cvtpk(float lo, float hi) { return pg8::cvt_pk_bf16(lo, hi); }
__device__ __forceinline__ float bflo(unsigned w) { return __uint_as_float(w << 16); }
__device__ __forceinline__ float bfhi(unsigned w) { return __uint_as_float(w & 0xffff0000u); }
__device__ __forceinline__ float fexp(float x) { return __builtin_amdgcn_exp2f(x * L2E); }
__device__ __forceinline__ float fsigmoid(float x) { return __builtin_amdgcn_rcpf(1.f + __builtin_amdgcn_exp2f(-x * L2E)); }
__device__ __forceinline__ f32x4 sig4(f32x4 v) { return (f32x4){fsigmoid(v[0]), fsigmoid(v[1]), fsigmoid(v[2]), fsigmoid(v[3])}; }
__device__ __forceinline__ v4u pk8g(f32x4 a, f32x4 b) { v4u w; w.x = cvtpk(a[0], a[1]); w.y = cvtpk(a[2], a[3]); w.z = cvtpk(b[0], b[1]); w.w = cvtpk(b[2], b[3]); return w; }
__device__ __forceinline__ void unpk8(v4u w, f32x4& a, f32x4& b) { a = (f32x4){bflo(w.x), bfhi(w.x), bflo(w.y), bfhi(w.y)}; b = (f32x4){bflo(w.z), bfhi(w.z), bflo(w.w), bfhi(w.w)}; }
__device__ __forceinline__ float wave_sum(float v) {
#pragma unroll
    for (int o = 1; o < 64; o <<= 1) v += __shfl_xor(v, o);
    return v;
}
template <int W> __device__ __forceinline__ size_t toff(int row, int col) { return ((size_t)(row >> 8) * (W / 64) + (col >> 6)) * 16384 + (size_t)(((row & 255) << 6) + (col & 63)); }
__device__ __forceinline__ int lane_id() { return (int)__builtin_amdgcn_mbcnt_hi(~0u, __builtin_amdgcn_mbcnt_lo(~0u, 0u)); }
__device__ __forceinline__ int sig16(int n) { return (n & ~12) | ((n & 4) << 1) | ((n & 8) >> 1); }

struct WDesc { const float* W; const float* gain; bf16* WT; int K, Nsrc, mat; };
__device__ __forceinline__ int src_col(int mat, int n) {
    if (mat == 0) {
        if (n < 1024) return sig16(n);
        if (n < 3072) return n;
        if (n < 5120) return 3664 + (n - 3072);
        if (n < 5376) return 3088 + (n - 5120);
        if (n < 5632) return 3344 + (n - 5376);
        const int j = n - 5632; if (j < 64) return 3600 + (j >> 1) + 32 * (j & 1); if (j < 80) return 3072 + (j - 64); return -1;
    }
    if (mat == 2) {
        if (n < 1024) return (n >> 7) * 192 + (n & 127);
        const int mm = n - 1024, hh = mm >> 6, j = mm & 63; return hh * 192 + 128 + (j >> 1) + 32 * (j & 1);
    }
    if (mat == 3) {
        if (n < 1024) return (n >> 7) * 256 + (n & 127);
        const int mm = n - 1024; return (mm >> 7) * 256 + 128 + (mm & 127);
    }
    return n;
}
__device__ __forceinline__ void wt_item(const float* W, const float* gain, bf16* WT, int K, int Nsrc, int Ndst, int mat, const float* Wup, LAS float* scr, int item, int lane) {
    const int nblk = Ndst / 32, kb = item / nblk, nb = item % nblk, k0 = 64 * kb, n0 = 32 * nb;
    int sc; const float* Ws = W;
    if (mat == 6) { const int pn = n0 >> 8, r0 = n0 & 255; if (r0 >= 128) Ws = Wup; sc = 128 * pn + (r0 & 127) + (lane & 31); }
    else sc = src_col(mat, n0 + (lane & 31));
#pragma unroll 8
    for (int i = 0; i < 32; ++i) { const int kk = 2 * i + (lane >> 5); float v = 0.f; if (sc >= 0) v = ((const GAS float*)Ws)[(size_t)(k0 + kk) * Nsrc + sc]; if (gain) v *= ((const GAS float*)gain)[k0 + kk]; scr[kk * 33 + (lane & 31)] = v; }
    LDS_WAIT(); asm volatile("" ::: "memory");
    const int c = lane & 7;
#pragma unroll
    for (int j = 0; j < 4; ++j) { const int n = (lane >> 3) + 8 * j; const LAS float* s = scr + (8 * c) * 33 + n;
        v4u o; o.x = cvtpk(s[0 * 33], s[1 * 33]); o.y = cvtpk(s[2 * 33], s[3 * 33]); o.z = cvtpk(s[4 * 33], s[5 * 33]); o.w = cvtpk(s[6 * 33], s[7 * 33]);
        *(GAS v4u*)(WT + (size_t)(n0 + n) * K + k0 + 8 * c) = o; }
    LDS_WAIT(); asm volatile("" ::: "memory");
}
__device__ __forceinline__ void sincos_d(double r, double& s, double& c) {
    const double r2 = r * r; double ts = 1.0, tc = 1.0, ss = 1.0, cc = 1.0;
#pragma unroll
    for (int k = 1; k <= 13; ++k) { tc *= -r2 / (double)((2 * k - 1) * (2 * k)); ts *= -r2 / (double)((2 * k) * (2 * k + 1)); cc += tc; ss += ts; }
    s = ss * r; c = cc;
}
__device__ __forceinline__ const float* in_ptr(int k);
__device__ __forceinline__ void p0_prologue(unsigned char* ws, LAS unsigned char* lds, int vcu, int G, int wave, int lane, int tid) {
    LAS float* scr = (LAS float*)(lds + wave * 16384);
    const int gw = vcu * NWAVES + wave, NGW = G * NWAVES;
    constexpr int I_IN = 16 * (NIN / 32), I_SQ = 16 * 32, I_UQ = 4 * 48, I_UKV = 4 * 64, I_GU = 16 * (NGU / 32), I_DN = 44 * 32, I_PLE = 4 * 32;
    constexpr int NITEMS = I_IN + I_SQ + I_UQ + I_UKV + I_SQ + I_SQ + I_GU + I_DN + I_PLE + I_SQ;
    for (int it = gw; it < NITEMS; it += NGW) {
        int r = it;
        if (r < I_IN)  { wt_item(in_ptr(5), nullptr, (bf16*)(ws + WS_WIN), 1024, 5712, NIN, 0, nullptr, scr, r, lane); continue; } r -= I_IN;
        if (r < I_SQ)  { wt_item(in_ptr(9), nullptr, (bf16*)(ws + WS_WMO), 1024, 1024, 1024, 1, nullptr, scr, r, lane); continue; } r -= I_SQ;
        if (r < I_UQ)  { wt_item(in_ptr(11), in_ptr(10), (bf16*)(ws + WS_WUQ), 256, 1536, 1536, 2, nullptr, scr, r, lane); continue; } r -= I_UQ;
        if (r < I_UKV) { wt_item(in_ptr(13), in_ptr(12), (bf16*)(ws + WS_WUKV), 256, 2048, 2048, 3, nullptr, scr, r, lane); continue; } r -= I_UKV;
        if (r < I_SQ)  { wt_item(in_ptr(14), nullptr, (bf16*)(ws + WS_WAO), 1024, 1024, 1024, 1, nullptr, scr, r, lane); continue; } r -= I_SQ;
        if (r < I_SQ)  { wt_item(in_ptr(15), nullptr, (bf16*)(ws + WS_WOUT), 1024, 1024, 1024, 1, nullptr, scr, r, lane); continue; } r -= I_SQ;
        if (r < I_GU)  { wt_item(in_ptr(17), in_ptr(16), (bf16*)(ws + WS_WGU), 1024, DFF, NGU, 6, in_ptr(18), scr, r, lane); continue; } r -= I_GU;
        if (r < I_DN)  { wt_item(in_ptr(19), nullptr, (bf16*)(ws + WS_WDN), DFF, 1024, 1024, 1, nullptr, scr, r, lane); continue; } r -= I_DN;
        if (r < I_PLE) { wt_item(in_ptr(20), nullptr, (bf16*)(ws + WS_WPLE), 256, 1024, 1024, 1, nullptr, scr, r, lane); continue; } r -= I_PLE;
        wt_item(in_ptr(21), nullptr, (bf16*)(ws + WS_WPG), 1024, 1024, 1024, 1, nullptr, scr, r, lane);
    }
    {
        const GAS f32x4* gm = (const GAS f32x4*)in_ptr(4) + lane; f32x4 gv[4];
#pragma unroll
        for (int j = 0; j < 4; ++j) gv[j] = gm[64 * j];
        bf16* H = (bf16*)(ws + WS_R1);
        for (int m = gw; m < M; m += 2 * NGW) {
            const int m2 = m + NGW; const bool has2 = m2 < M; const int mb = has2 ? m2 : m;
            const float* xrow = (m < MP) ? in_ptr(0) + (size_t)m * DM : in_ptr(1) + (size_t)(m - MP) * DM;
            const float* xrow2 = (mb < MP) ? in_ptr(0) + (size_t)mb * DM : in_ptr(1) + (size_t)(mb - MP) * DM;
            const GAS f32x4* xr = (const GAS f32x4*)xrow + lane; const GAS f32x4* xr2 = (const GAS f32x4*)xrow2 + lane; f32x4 v[4], w[4]; float s = 0.f, s2 = 0.f;
#pragma unroll
            for (int j = 0; j < 4; ++j) { v[j] = xr[64 * j]; w[j] = xr2[64 * j]; }
#pragma unroll
            for (int j = 0; j < 4; ++j) { s += (v[j].x * v[j].x + v[j].y * v[j].y) + (v[j].z * v[j].z + v[j].w * v[j].w); s2 += (w[j].x * w[j].x + w[j].y * w[j].y) + (w[j].z * w[j].z + w[j].w * w[j].w); }
            const float rstd = 1.0f / sqrtf(wave_sum(s) * (1.f / DM) + EPS), rstd2 = 1.0f / sqrtf(wave_sum(s2) * (1.f / DM) + EPS);
#pragma unroll
            for (int j = 0; j < 4; ++j) *(GAS unsigned long long*)(H + toff<1024>(m, 4 * lane + 256 * j)) = (unsigned long long)cvtpk(v[j].x * rstd * gv[j].x, v[j].y * rstd * gv[j].y) | ((unsigned long long)cvtpk(v[j].z * rstd * gv[j].z, v[j].w * rstd * gv[j].w) << 32);
            if (has2) {
#pragma unroll
                for (int j = 0; j < 4; ++j) *(GAS unsigned long long*)(H + toff<1024>(mb, 4 * lane + 256 * j)) = (unsigned long long)cvtpk(w[j].x * rstd2 * gv[j].x, w[j].y * rstd2 * gv[j].y) | ((unsigned long long)cvtpk(w[j].z * rstd2 * gv[j].z, w[j].w * rstd2 * gv[j].w) << 32); }
        }
    }
    {
        bf16* PB = (bf16*)(ws + WS_PB); const long n8 = (long)M * 256 / 8, np8 = (long)MP * 256 / 8;
        for (long i = (long)gw * 64 + lane; i < n8; i += (long)NGW * 64) {
            const float* src = (i < np8) ? in_ptr(2) + i * 8 : in_ptr(3) + (i - np8) * 8;
            const f32x4 a = *(const GAS f32x4*)src, b = *(const GAS f32x4*)(src + 4);
            *(GAS v4u*)(PB + toff<256>((int)(i >> 5), (int)(i & 31) * 8)) = pk8g(a, b);
        }
    }
    {
        f32x2g* tab = (f32x2g*)(ws + WS_TAB);
        for (int e = gw * 64 + lane; e < SEQ * 32; e += NGW * 64) {
            const int pos = e >> 5, i = e & 31;
            const double invf = exp(-(double)i * (9.210340371976184 / 32.0));
            const double ang = (double)pos * invf;
            const double k = rint(ang * 0.15915494309189535);
            const double r = ang - k * 6.283185307179586;
            double s, c; sincos_d(r, s, c);
            tab[e] = (f32x2g){(float)c, (float)s};
        }
    }
}

__device__ __forceinline__ void t1_conv(const bf16* QKraw, bf16* QKc, const float* conv_w, int gw, int NGW, int lane) {
    constexpr int NITEM = (M / 8) * 2;
    for (int hf = 0; hf < 2; ++hf) {
        const int c0 = hf * 512 + lane * 8;
        float w[5][8];
#pragma unroll
        for (int j = 0; j < 5; ++j)
#pragma unroll
            for (int k = 0; k < 8; ++k) w[j][k] = ((const GAS float*)conv_w)[j * 1024 + sig16(c0 + k)];
        const float osc = (hf == 0) ? 0.08838834764831845f : 1.0f;
        for (int it = gw; it < NITEM / 2; it += NGW) {
            const int row0 = it * 8, t0 = row0 & (SEQ - 1);
            v4u raw[12];
#pragma unroll
            for (int j = 0; j < 12; ++j) { const int t = t0 + j - 2; raw[j] = (v4u){0u, 0u, 0u, 0u}; if (t >= 0 && t < SEQ) raw[j] = *(const GAS v4u*)(QKraw + toff<1024>(row0 + j - 2, c0)); }
#pragma unroll
            for (int i = 0; i < 8; ++i) {
                f32x4 oa = (f32x4){0.f, 0.f, 0.f, 0.f}, ob = oa;
#pragma unroll
                for (int j = 0; j < 5; ++j) { f32x4 xa, xb; unpk8(raw[i + j], xa, xb);
#pragma unroll
                    for (int k = 0; k < 4; ++k) { oa[k] += xa[k] * w[j][k]; ob[k] += xb[k] * w[j][4 + k]; } }
#pragma unroll
                for (int k = 0; k < 4; ++k) { oa[k] = oa[k] * fsigmoid(oa[k]) * osc; ob[k] = ob[k] * fsigmoid(ob[k]) * osc; }
                *(GAS v4u*)(QKc + (size_t)(row0 + i) * 1024 + c0) = pk8g(oa, ob);
            }
        }
    }
}

__device__ __forceinline__ void t2_combine(const bf16* HMf, const bf16* HMb, bf16* OA, const float* g_mhead, int gw, int NGW, int lane) {
    f32x4 ga[2], gb[2];
#pragma unroll
    for (int i = 0; i < 2; ++i) { ga[i] = *(const GAS f32x4*)(g_mhead + 512 * i + 8 * lane); gb[i] = *(const GAS f32x4*)(g_mhead + 512 * i + 8 * lane + 4); }
    for (int m0 = gw; m0 < M; m0 += 2 * NGW) {
        v4u rf[2][2], rb[2][2], ro[2][2];
#pragma unroll
        for (int q = 0; q < 2; ++q) { const int m = (m0 + q * NGW < M) ? m0 + q * NGW : m0;
#pragma unroll
            for (int i = 0; i < 2; ++i) { const size_t off = (size_t)m * 1024 + 512 * i + 8 * lane;
                rf[q][i] = *(const GAS v4u*)(HMf + off); rb[q][i] = *(const GAS v4u*)(HMb + off); ro[q][i] = *(const GAS v4u*)(OA + toff<1024>(m, 512 * i + 8 * lane)); } }
#pragma unroll
        for (int q = 0; q < 2; ++q) { const int m = m0 + q * NGW; if (m >= M) break;
#pragma unroll
            for (int i = 0; i < 2; ++i) {
                f32x4 fa, fb, ba, bb, oa, ob;
                unpk8(rf[q][i], fa, fb); unpk8(rb[q][i], ba, bb); unpk8(ro[q][i], oa, ob);
                fa += ba; fb += bb;
                float s = (fa[0] * fa[0] + fa[1] * fa[1]) + (fa[2] * fa[2] + fa[3] * fa[3]) + (fb[0] * fb[0] + fb[1] * fb[1]) + (fb[2] * fb[2] + fb[3] * fb[3]);
#pragma unroll
                for (int o = 1; o < 32; o <<= 1) s += __shfl_xor(s, o);
                const float rstd = 1.0f / sqrtf(s * (1.f / 256.f) + EPS);
                fa = fa * rstd * ga[i] * oa; fb = fb * rstd * gb[i] * ob;
                *(GAS v4u*)(OA + toff<1024>(m, 512 * i + 8 * lane)) = pk8g(fa, fb);
            } }
    }
}

__device__ __forceinline__ void t4_final(const bf16* src, float* out, const float* g_final, int gw, int NGW, int lane) {
    f32x4 ga[2], gb[2];
#pragma unroll
    for (int i = 0; i < 2; ++i) { ga[i] = *(const GAS f32x4*)(g_final + 512 * i + 8 * lane); gb[i] = *(const GAS f32x4*)(g_final + 512 * i + 8 * lane + 4); }
    for (int m0 = gw; m0 < M; m0 += 4 * NGW) {
        v4u raw[4][2];
#pragma unroll
        for (int q = 0; q < 4; ++q) { const int m = (m0 + q * NGW < M) ? m0 + q * NGW : m0;
#pragma unroll
            for (int i = 0; i < 2; ++i) raw[q][i] = *(const GAS v4u*)(src + toff<1024>(m, 512 * i + 8 * lane)); }
#pragma unroll
        for (int q = 0; q < 4; ++q) { const int m = m0 + q * NGW; if (m >= M) break;
            f32x4 xa[2], xb[2]; float s = 0.f;
#pragma unroll
            for (int i = 0; i < 2; ++i) { unpk8(raw[q][i], xa[i], xb[i]); s += (xa[i][0] * xa[i][0] + xa[i][1] * xa[i][1]) + (xa[i][2] * xa[i][2] + xa[i][3] * xa[i][3]) + (xb[i][0] * xb[i][0] + xb[i][1] * xb[i][1]) + (xb[i][2] * xb[i][2] + xb[i][3] * xb[i][3]); }
            const float rstd = 1.0f / sqrtf(wave_sum(s) * (1.f / DM) + EPS);
#pragma unroll
            for (int i = 0; i < 2; ++i) { float* o = out + (size_t)m * DM + 512 * i + 8 * lane; *(GAS f32x4*)o = xa[i] * rstd * ga[i]; *(GAS f32x4*)(o + 4) = xb[i] * rstd * gb[i]; }
        }
    }
}

#define KSWZ(row, colB) ((row) * 256 + ((colB) ^ (((row) & 7) << 4)))
#define KSWZA(row, colB) ((row) * 256 + ((colB) ^ ((((row) & 7) | (((row) >> 1) & 8)) << 4)))
#define KRSWZ(row, colB) ((row) * 128 + ((colB) ^ ((((row) >> 1) & 7) << 4)))
#define SBAR() __builtin_amdgcn_sched_barrier(0)
__device__ __forceinline__ int crow(int r, int hi) { return (r & 3) + 8 * (r >> 2) + 4 * hi; }
__device__ __forceinline__ int v_st(int k, int c) { const int kk = (k & ~0xC) | ((k & 4) << 1) | ((k & 8) >> 1); return ((kk >> 3) * 4 + (c >> 5)) * 512 + ((kk & 7) * 32 + (c & 31)) * 2; }
__device__ __forceinline__ int v_rd_base(int lane) { return ((lane & 3) << 3) | (((lane >> 2) & 3) << 6) | (((lane >> 4) & 1) << 5) | (((lane >> 5) & 1) << 8); }
constexpr int v_rd_off(int d0, int ks, int half) { return d0 * 512 + ks * 4096 + half * 2048; }
template <int OFF> __device__ __forceinline__ s16x4 tr_read(int vb) {
    s16x4 r; asm volatile("ds_read_b64_tr_b16 %0, %1 offset:%2" : "=&v"(r) : "v"(vb), "i"(OFF) : "memory"); return r;
}
#define PKF(L, H) (bf16x8){L[0], L[1], L[2], L[3], H[0], H[1], H[2], H[3]}
#define PK4(P, BASE, OUT) do { unsigned a0_ = cvtpk(P[BASE + 0], P[BASE + 1]), a1_ = cvtpk(P[BASE + 2], P[BASE + 3]);   \
    unsigned b0_ = cvtpk(P[BASE + 4], P[BASE + 5]), b1_ = cvtpk(P[BASE + 6], P[BASE + 7]);                              \
    auto r0_ = __builtin_amdgcn_permlane32_swap(a0_, b0_, false, false); auto r1_ = __builtin_amdgcn_permlane32_swap(a1_, b1_, false, false); \
    v4u w_ = {r0_[0], r1_[0], r0_[1], r1_[1]}; OUT = __builtin_bit_cast(bf16x8, w_); } while (0)
__device__ __forceinline__ float swap_add(float x) { auto rr = __builtin_amdgcn_permlane32_swap(__float_as_uint(x), __float_as_uint(x), false, false); return __uint_as_float(rr[0]) + __uint_as_float(rr[1]); }
__device__ __forceinline__ float swap_max(float x) { auto rr = __builtin_amdgcn_permlane32_swap(__float_as_uint(x), __float_as_uint(x), false, false); return fmaxf(__uint_as_float(rr[0]), __uint_as_float(rr[1])); }

namespace att {
constexpr int NW = 8, QBLK = 32, KVBLK = 64;
constexpr float SCALE = 0.07216878364870322f;
constexpr float THR = 8.f;
constexpr int SHM_V = 16384, SHM_K = 16384, SHM_KR = 8192;
constexpr int OFF_V = 0, OFF_K = 3 * SHM_V, OFF_KR = OFF_K + 2 * SHM_K, OFF_WS = OFF_KR + 2 * SHM_KR, OFF_QR = OFF_WS + NW * 64 * 4, ATT_LDS = OFF_QR + NW * 7168;
constexpr int LDQN = 1024, LDQR = 512, LDK = 1024, LDKR = 64, LDO = 1024;

__device__ __forceinline__ void smax(const f32x16& p0, const f32x16& p1, float& m_reg, float& mn, float& alpha) {
    constexpr float C = SCALE * L2E;
    float pmax = p0[0];
#pragma unroll
    for (int r = 1; r < 16; ++r) pmax = fmaxf(pmax, p0[r]);
#pragma unroll
    for (int r = 0; r < 16; ++r) pmax = fmaxf(pmax, p1[r]);
    pmax = swap_max(pmax);
    if (__builtin_expect(__all(pmax - m_reg <= THR / SCALE), 1)) { mn = m_reg; alpha = 1.f; }
    else { mn = fmaxf(m_reg, pmax); alpha = __builtin_amdgcn_exp2f((m_reg - mn) * C); m_reg = mn; }
}
__device__ __forceinline__ void sexp0(f32x16& p0, f32x16& p1, float mn) {
    constexpr float C = SCALE * L2E;
    const float mnC = -mn * C;
#pragma unroll
    for (int r = 0; r < 16; ++r) p0[r] = fmaf(p0[r], C, mnC);
#pragma unroll
    for (int r = 0; r < 16; ++r) p1[r] = fmaf(p1[r], C, mnC);
#pragma unroll
    for (int r = 0; r < 16; ++r) p0[r] = __builtin_amdgcn_exp2f(p0[r]);
}
__device__ __forceinline__ void partialSM(f32x16& p0, f32x16& p1, float& m_reg, float& mn, float& alpha) { smax(p0, p1, m_reg, mn, alpha); sexp0(p0, p1, mn); }
__device__ __forceinline__ void finishSM(f32x16& p0, f32x16& p1, float alpha, float& l_reg, bf16x8& pa0, bf16x8& pa1, bf16x8& pa2, bf16x8& pa3) {
#pragma unroll
    for (int r = 0; r < 16; ++r) p1[r] = __builtin_amdgcn_exp2f(p1[r]);
    float ps = 0;
#pragma unroll
    for (int r = 0; r < 16; ++r) ps += p0[r];
#pragma unroll
    for (int r = 0; r < 16; ++r) ps += p1[r];
    ps = swap_add(ps);
    l_reg = l_reg * alpha + ps;
    PK4(p0, 0, pa0); PK4(p0, 8, pa1); PK4(p1, 0, pa2); PK4(p1, 8, pa3);
}
__device__ __forceinline__ bf16x8 ldsf(unsigned a) { return *(const LAS bf16x8*)a; }
template <int VAR = 0> __device__ __forceinline__ void qkt(f32x16& p0, f32x16& p1, unsigned ka_, unsigned kra_, const bf16x8* qr, unsigned qa_) {
    unsigned ka = ka_, kra = kra_, qa = qa_; asm volatile("" : "+v"(ka), "+v"(kra), "+v"(qa));
#pragma unroll
    for (int r = 0; r < 16; ++r) { p0[r] = 0.f; p1[r] = 0.f; }
#pragma unroll
    for (int d0 = 0; d0 < 8; ++d0) { const unsigned a = ka ^ (d0 << 5);
        const bf16x8 b0 = ldsf(a);
        const bf16x8 b1 = ldsf(a + 8192);
        bf16x8 qx; if (d0 < 5 || VAR == 1) qx = qr[d0 % 5]; else qx = ldsf(qa + (d0 - 5) * 1024);
        p0 = __builtin_amdgcn_mfma_f32_32x32x16_bf16(b0, qx, p0, 0, 0, 0);
        p1 = __builtin_amdgcn_mfma_f32_32x32x16_bf16(b1, qx, p1, 0, 0, 0); }
    if (VAR != 2)
#pragma unroll
    for (int d0 = 0; d0 < 4; ++d0) { const unsigned a = kra ^ (d0 << 5);
        const bf16x8 b0 = ldsf(a);
        const bf16x8 b1 = ldsf(a + 4096);
        const bf16x8 qx = (VAR == 1) ? qr[d0] : ldsf(qa + 3072 + d0 * 1024);
        p0 = __builtin_amdgcn_mfma_f32_32x32x16_bf16(b0, qx, p0, 0, 0, 0);
        p1 = __builtin_amdgcn_mfma_f32_32x32x16_bf16(b1, qx, p1, 0, 0, 0); }
}
template <int D0> __device__ __forceinline__ void pv_one(f32x16& od, int vb, bf16x8 pa0, bf16x8 pa1, bf16x8 pa2, bf16x8 pa3) {
    const s16x4 l0 = tr_read<v_rd_off(D0, 0, 0)>(vb), h0 = tr_read<v_rd_off(D0, 0, 1)>(vb), l1 = tr_read<v_rd_off(D0, 1, 0)>(vb), h1 = tr_read<v_rd_off(D0, 1, 1)>(vb);
    const s16x4 l2 = tr_read<v_rd_off(D0, 2, 0)>(vb), h2 = tr_read<v_rd_off(D0, 2, 1)>(vb), l3 = tr_read<v_rd_off(D0, 3, 0)>(vb), h3 = tr_read<v_rd_off(D0, 3, 1)>(vb);
    asm volatile("s_waitcnt lgkmcnt(0)" ::: "memory"); SBAR();
    od = __builtin_amdgcn_mfma_f32_32x32x16_bf16(pa0, PKF(l0, h0), od, 0, 0, 0);
    od = __builtin_amdgcn_mfma_f32_32x32x16_bf16(pa1, PKF(l1, h1), od, 0, 0, 0);
    od = __builtin_amdgcn_mfma_f32_32x32x16_bf16(pa2, PKF(l2, h2), od, 0, 0, 0);
    od = __builtin_amdgcn_mfma_f32_32x32x16_bf16(pa3, PKF(l3, h3), od, 0, 0, 0);
}
__device__ __forceinline__ void pv_d0(f32x16* o, int vb, bf16x8 pa0, bf16x8 pa1, bf16x8 pa2, bf16x8 pa3) {
    pv_one<0>(o[0], vb, pa0, pa1, pa2, pa3); pv_one<1>(o[1], vb, pa0, pa1, pa2, pa3); pv_one<2>(o[2], vb, pa0, pa1, pa2, pa3); pv_one<3>(o[3], vb, pa0, pa1, pa2, pa3);
}
template <int VAR = 0> __device__ __forceinline__ void qk_fsm(f32x16& n0, f32x16& n1, unsigned ka_, unsigned kra_, const bf16x8* qr, unsigned qa_,
                                                              f32x16& e0, f32x16& e1, float alpha, float& l_reg, bf16x8& pa0, bf16x8& pa1, bf16x8& pa2, bf16x8& pa3) {
    unsigned ka = ka_, kra = kra_, qa = qa_; asm volatile("" : "+v"(ka), "+v"(kra), "+v"(qa));
    bf16x8 fb0[2], fb1[2], fq[2]; float ps = 0.f;
#define QK_LOAD(S) do { const int s_ = (S); const unsigned a_ = s_ < 8 ? (ka ^ (s_ << 5)) : (kra ^ ((s_ - 8) << 5)); \
        fb0[s_ & 1] = ldsf(a_); fb1[s_ & 1] = ldsf(a_ + (s_ < 8 ? 8192 : 4096)); \
        if (s_ < 5) fq[s_ & 1] = qr[s_]; else fq[s_ & 1] = ldsf(qa + (s_ - 5) * 1024); } while (0)
    QK_LOAD(0);
#pragma unroll
    for (int s = 0; s < 12; ++s) {
        if (s < 11) QK_LOAD(s + 1);
        SBAR();
        if (s == 0) { f32x16 z; _Pragma("unroll") for (int r = 0; r < 16; ++r) z[r] = 0.f; n0 = __builtin_amdgcn_mfma_f32_32x32x16_bf16(fb0[0], fq[0], z, 0, 0, 0); }
        else n0 = __builtin_amdgcn_mfma_f32_32x32x16_bf16(fb0[s & 1], fq[s & 1], n0, 0, 0, 0);
        if (s < 8) { e1[2 * s] = __builtin_amdgcn_exp2f(e1[2 * s]); e1[2 * s + 1] = __builtin_amdgcn_exp2f(e1[2 * s + 1]); }
        if (s < 4) { ps += e0[4 * s]; ps += e0[4 * s + 1]; }
        if (s == 0) { f32x16 z; _Pragma("unroll") for (int r = 0; r < 16; ++r) z[r] = 0.f; n1 = __builtin_amdgcn_mfma_f32_32x32x16_bf16(fb1[0], fq[0], z, 0, 0, 0); }
        else n1 = __builtin_amdgcn_mfma_f32_32x32x16_bf16(fb1[s & 1], fq[s & 1], n1, 0, 0, 0);
        if (s < 4) { ps += e0[4 * s + 2]; ps += e0[4 * s + 3]; } else { ps += e1[2 * (s - 4)]; ps += e1[2 * (s - 4) + 1]; }
        if (s == 4) PK4(e0, 0, pa0);
        if (s == 5) PK4(e0, 8, pa1);
        if (s == 8) PK4(e1, 0, pa2);
        if (s == 9) PK4(e1, 8, pa3);
        if (s == 11) { ps = swap_add(ps); l_reg = l_reg * alpha + ps; }
        SBAR();
    }
#undef QK_LOAD
}
template <int I> __device__ __forceinline__ void pv_rd(s16x4 (&vl)[4], s16x4 (&vh)[4], unsigned vb) {
    vl[I & 3] = tr_read<v_rd_off(I >> 2, I & 3, 0)>((int)vb); vh[I & 3] = tr_read<v_rd_off(I >> 2, I & 3, 1)>((int)vb);
}
template <int I> __device__ __forceinline__ void pv_step(f32x16* o, s16x4 (&vl)[4], s16x4 (&vh)[4], unsigned vb, bf16x8 pa0, bf16x8 pa1, bf16x8 pa2, bf16x8 pa3,
                                                         f32x16& n0, f32x16& n1, float& pm, float& m_reg, float& mn, float& alpha, float& mnC) {
    constexpr float C = SCALE * L2E;
    if (I + 3 < 16) pv_rd<(I + 3 < 16) ? I + 3 : 0>(vl, vh, vb);
    if (I < 13) asm volatile("s_waitcnt lgkmcnt(6)" ::: "memory"); else if (I == 13) asm volatile("s_waitcnt lgkmcnt(4)" ::: "memory");
    else if (I == 14) asm volatile("s_waitcnt lgkmcnt(2)" ::: "memory"); else asm volatile("s_waitcnt lgkmcnt(0)" ::: "memory");
    SBAR();
    const bf16x8 pa = (I & 3) == 0 ? pa0 : (I & 3) == 1 ? pa1 : (I & 3) == 2 ? pa2 : pa3;
    o[I >> 2] = __builtin_amdgcn_mfma_f32_32x32x16_bf16(pa, PKF(vl[I & 3], vh[I & 3]), o[I >> 2], 0, 0, 0);
    if (I < 8) { const float t = fmaxf(fmaxf(n0[2 * I], n0[2 * I + 1]), fmaxf(n1[2 * I], n1[2 * I + 1])); pm = (I == 0) ? t : fmaxf(pm, t); }
    if (I == 8) {
        const float pmax = swap_max(pm);
        if (__builtin_expect(__all(pmax - m_reg <= THR / SCALE), 1)) { mn = m_reg; alpha = 1.f; }
        else { mn = fmaxf(m_reg, pmax); alpha = __builtin_amdgcn_exp2f((m_reg - mn) * C); m_reg = mn; }
        mnC = -mn * C;
    }
    if (I > 8) { constexpr int k = I > 8 ? I - 9 : 0; constexpr int lo = (16 * k) / 7, hi = (16 * (k + 1)) / 7;
#pragma unroll
        for (int r = lo; r < hi; ++r) { float x0 = __builtin_amdgcn_exp2f(fmaf(n0[r], C, mnC)), x1 = fmaf(n1[r], C, mnC); asm volatile("" : "+v"(x0), "+v"(x1)); n0[r] = x0; n1[r] = x1; } }
    SBAR();
}
__device__ __forceinline__ void pv_sm(f32x16* o, unsigned vb, bf16x8 pa0, bf16x8 pa1, bf16x8 pa2, bf16x8 pa3, f32x16& n0, f32x16& n1, float& m_reg, float& mn, float& alpha) {
    s16x4 vl[4], vh[4]; float pm = 0.f, mnC = 0.f;
    pv_rd<0>(vl, vh, vb); pv_rd<1>(vl, vh, vb); pv_rd<2>(vl, vh, vb);
#define PVS(I) pv_step<I>(o, vl, vh, vb, pa0, pa1, pa2, pa3, n0, n1, pm, m_reg, mn, alpha, mnC)
    PVS(0); PVS(1); PVS(2); PVS(3); PVS(4); PVS(5); PVS(6); PVS(7); PVS(8); PVS(9); PVS(10); PVS(11); PVS(12); PVS(13); PVS(14); PVS(15);
#undef PVS
}
template <int VAR = 0> __device__ __forceinline__ void attn_unit(const bf16* QnT, const bf16* QrT, const bf16* KnT, const bf16* Kr0, const bf16* VaT, bf16* OT, int r0, int qb, int hh, char* lds,
                                                                 int nr0 = 0, int nqb = -1, int nhh = 0) {
    int tid_o = threadIdx.x; asm volatile("" : "+v"(tid_o));
    const int tid = tid_o, wid = tid >> 6, lane = tid & 63, r32 = lane & 31, hi = lane >> 5;
#ifdef ATPROBE_SEG
#ifndef ATPROBE_TID
#define ATPROBE_TID 0
#endif
#define ATSTAMP(k) do { SBAR(); if (blockIdx.x == 0 && threadIdx.x == ATPROBE_TID) { const unsigned now_ = (unsigned)__builtin_amdgcn_s_memrealtime(); if ((k) == ATPROBE_SEG) atp_t0 = now_; if ((k) == ATPROBE_SEG + 1) *(volatile unsigned*)(lds + 163840 - 64) += now_ - atp_t0; } SBAR(); } while (0)
    unsigned atp_t0 = 0;
#else
#define ATSTAMP(k) do {} while (0)
#endif
    ATSTAMP(11);
    char* V_lds = lds + OFF_V; char* K_lds = lds + OFF_K; char* KR_lds = lds + OFF_KR;
    float* ws = (float*)(lds + OFF_WS) + wid * 64; float* li_l = ws; float* al_l = ws + 32;
    float m_reg = -1e30f, l_reg = 0; f32x16 o[4]; bf16x8 qr[5]; char* qrl = lds + OFF_QR + wid * 7168;
#pragma unroll
    for (int d = 0; d < 4; ++d)
#pragma unroll
        for (int r = 0; r < 16; ++r) o[d][r] = 0.f;
    const unsigned vb0 = (unsigned)(uintptr_t)V_lds + v_rd_base(lane);
    const unsigned ka0 = (unsigned)(uintptr_t)K_lds + KSWZA(r32, hi * 16), kra0 = (unsigned)(uintptr_t)KR_lds + KRSWZ(r32, hi * 16), qa0 = (unsigned)(uintptr_t)qrl + lane * 16;
    const int wu = __builtin_amdgcn_readfirstlane(wid);
    unsigned kofA, kofR, vofA;
    { const int rowA = 4 * wu + (lane >> 4), cA_ = (lane & 15) ^ ((rowA & 7) | ((rowA >> 1) & 8));
      kofA = (unsigned)((cA_ >> 3) * 16384 + rowA * 64 + (cA_ & 7) * 8);
      const int rowR = 8 * wu + (lane >> 3), cR_ = (lane & 7) ^ ((rowR >> 1) & 7); kofR = (unsigned)(rowR * LDKR + cR_ * 8);
      const int subA = 2 * wu + (lane >> 5), kl = (lane & 31) >> 2, cc = (lane & 3) * 8;
      const int kkA = (subA >> 2) * 8 + kl, kA_ = (kkA & ~0xC) | ((kkA & 4) << 1) | ((kkA & 8) >> 1);
      const int vcA = (subA & 3) * 32 + cc;
      vofA = (unsigned)((vcA >> 6) * 16384 + kA_ * 64 + (vcA & 63)); }
#define TDMA(kb, vbuf, k0) do { const size_t tb_ = toff<1024>(r0 + (k0), hh * 128); const bf16* kt_ = KnT + tb_; const bf16* vt_ = VaT + tb_; const bf16* rt_ = Kr0 + (size_t)(r0 + (k0)) * LDKR; \
    __builtin_amdgcn_global_load_lds((const unsigned*)(kt_ + kofA), (LAS unsigned*)(K_lds + (kb) * SHM_K + wu * 1024), 16, 0, 0); \
    __builtin_amdgcn_global_load_lds((const unsigned*)(kt_ + kofA + 2048), (LAS unsigned*)(K_lds + (kb) * SHM_K + 8192 + wu * 1024), 16, 0, 0); \
    __builtin_amdgcn_global_load_lds((const unsigned*)(rt_ + kofR), (LAS unsigned*)(KR_lds + (kb) * SHM_KR + wu * 1024), 16, 0, 0); \
    __builtin_amdgcn_global_load_lds((const unsigned*)(vt_ + vofA), (LAS unsigned*)(V_lds + (vbuf) * SHM_V + wu * 1024), 16, 0, 0); \
    __builtin_amdgcn_global_load_lds((const unsigned*)(vt_ + vofA + 2048), (LAS unsigned*)(V_lds + (vbuf) * SHM_V + 8192 + wu * 1024), 16, 0, 0); } while (0)
#define SWAIT() asm volatile("s_waitcnt vmcnt(0)" ::: "memory")
#define RESC(a) do { if (__any((a) < 1.f)) { if (hi == 0) al_l[r32] = (a); asm volatile("s_waitcnt lgkmcnt(0)" ::: "memory"); \
    _Pragma("unroll") for (int d = 0; d < 4; ++d) _Pragma("unroll") for (int r = 0; r < 16; ++r) o[d][r] *= al_l[crow(r, hi)]; } } while (0)
    f32x16 pA0, pA1, pB0, pB1; float mnA, mnB, alA, alB; bf16x8 pa0, pa1, pa2, pa3; constexpr int NT = SEQ / KVBLK;
    __syncthreads();
    TDMA(0, 0, 0); TDMA(1, 1, KVBLK);
    const int qrow = r0 + qb * 256 + wid * QBLK + r32;
#pragma unroll
    for (int d0 = 0; d0 < 5; ++d0) qr[d0] = *reinterpret_cast<const bf16x8*>(QnT + toff<1024>(qrow, hh * 128 + d0 * 16 + hi * 8));
#pragma unroll
    for (int d0 = 5; d0 < 8; ++d0) *reinterpret_cast<bf16x8*>(qrl + (d0 - 5) * 1024 + lane * 16) = *reinterpret_cast<const bf16x8*>(QnT + toff<1024>(qrow, hh * 128 + d0 * 16 + hi * 8));
#pragma unroll
    for (int d0 = 0; d0 < 4; ++d0) *reinterpret_cast<bf16x8*>(qrl + 3072 + d0 * 1024 + lane * 16) = *reinterpret_cast<const bf16x8*>(QrT + toff<512>(qrow, hh * 64 + d0 * 16 + hi * 8));
    SWAIT(); __syncthreads();
    qkt<VAR>(pA0, pA1, ka0, kra0, qr, qa0); partialSM(pA0, pA1, m_reg, mnA, alA);
    __syncthreads();
    int vcur = 0, vnxt = 2;
#define HALF_ITER(PN0, PN1, MN_N, AL_N, PO0, PO1, AL_O, KB) do { \
        SBAR(); ATSTAMP(1); qk_fsm<VAR>(PN0, PN1, ka0 + (KB) * SHM_K, kra0 + (KB) * SHM_KR, qr, qa0, PO0, PO1, AL_O, l_reg, pa0, pa1, pa2, pa3); ATSTAMP(2); \
        pv_sm(o, vb0 + vcur * SHM_V, pa0, pa1, pa2, pa3, PN0, PN1, m_reg, MN_N, AL_N); ATSTAMP(3); \
        RESC(AL_N); ATSTAMP(4); } while (0)
    ATSTAMP(12); ATSTAMP(7);
#ifndef NO_PRIO_YOUNG
    if (wu >= 4) __builtin_amdgcn_s_setprio(1);
#endif
    for (int j = 1; j + 1 < NT; j += 2) {
        TDMA(0, vnxt, (j + 1) * KVBLK);
        if (nqb >= 0 && j == NT - 17 + 2 * wu) {
            const int nrow0 = nr0 + nqb * 256 + wu * QBLK;
            __builtin_amdgcn_global_load_lds((const unsigned*)(QnT + toff<1024>(nrow0, nhh * 128) + (lane >> 5) * 16384 + (lane & 31) * 64), (LAS unsigned*)(lds + ATT_LDS), 16, 0, 0);
            __builtin_amdgcn_global_load_lds((const unsigned*)(QrT + toff<512>(nrow0, nhh * 64) + (lane & 31) * 64 + (lane >> 5) * 8), (LAS unsigned*)(lds + ATT_LDS), 16, 0, 0); }
        HALF_ITER(pB0, pB1, mnB, alB, pA0, pA1, alA, 1);
        SWAIT(); ATSTAMP(5); __syncthreads(); ATSTAMP(6);
        vcur = (vcur == 2) ? 0 : vcur + 1; vnxt = (vnxt == 2) ? 0 : vnxt + 1;
        TDMA(1, vnxt, (j + 2) * KVBLK);
        HALF_ITER(pA0, pA1, mnA, alA, pB0, pB1, alB, 0);
        SWAIT(); ATSTAMP(5); __syncthreads(); ATSTAMP(6);
        vcur = (vcur == 2) ? 0 : vcur + 1; vnxt = (vnxt == 2) ? 0 : vnxt + 1;
    }
    ATSTAMP(8);
#ifndef NO_PRIO_YOUNG
    __builtin_amdgcn_s_setprio(0);
#endif
    HALF_ITER(pB0, pB1, mnB, alB, pA0, pA1, alA, 1);
    vcur = (vcur == 2) ? 0 : vcur + 1;
    finishSM(pB0, pB1, alB, l_reg, pa0, pa1, pa2, pa3); SBAR();
    pv_d0(o, (int)vb0 + vcur * SHM_V, pa0, pa1, pa2, pa3);
#undef HALF_ITER
    ATSTAMP(9);
    if (hi == 0) li_l[r32] = l_reg; asm volatile("s_waitcnt lgkmcnt(0)" ::: "memory");
    {
        int le = lane; asm volatile("" : "+v"(le)); const int r32e = le & 31, hie = le >> 5;
        float rli[16];
#pragma unroll
        for (int r = 0; r < 16; ++r) rli[r] = __builtin_amdgcn_rcpf(li_l[crow(r, hie)]);
        bf16* Ow = OT + toff<1024>(r0 + qb * 256 + __builtin_amdgcn_readfirstlane(wid) * QBLK, hh * 128);
        const unsigned ob = (unsigned)(4 * hie * 64 + r32e);
#pragma unroll
        for (int r = 0; r < 16; ++r) { const unsigned orow = (unsigned)((r & 3) + 8 * (r >> 2));
#pragma unroll
            for (int d0 = 0; d0 < 4; ++d0) Ow[ob + orow * 64 + (d0 >> 1) * 16384 + (d0 & 1) * 32] = (bf16)(cvtpk(o[d0][r] * rli[r], 0.f) & 0xffffu); }
    }
#ifdef ATPROBE_WAIT
    asm volatile("s_waitcnt vmcnt(0)" ::: "memory");
#endif
    ATSTAMP(10);
#undef TDMA
#undef SWAIT
#undef RESC
}
}

namespace ml {
constexpr int QIMG = 0, KIMG = 16384, KAIMG = 32768, VIMG = 49152, NIMG = 81920, PIMG = 98304, RAOFF = 106496, WSCR = 107520, ML_LDS = WSCR + 8 * 1024;
typedef float f32x4m __attribute__((ext_vector_type(4)));
template <int CTRL, int ROWMASK> __device__ __forceinline__ float dpp_f(float ident, float v) {
    return __builtin_bit_cast(float, __builtin_amdgcn_update_dpp(__builtin_bit_cast(int, ident), __builtin_bit_cast(int, v), CTRL, ROWMASK, 0xf, false));
}
__device__ __forceinline__ float scan_add(float x, int) {
    x += dpp_f<0x111, 0xf>(0.f, x); x += dpp_f<0x112, 0xf>(0.f, x); x += dpp_f<0x114, 0xf>(0.f, x); x += dpp_f<0x118, 0xf>(0.f, x);
    x += dpp_f<0x142, 0xa>(0.f, x); x += dpp_f<0x143, 0xc>(0.f, x);
    return x;
}
__device__ __forceinline__ float scan_max(float x, int) {
    const float NI = -3.0e38f;
    x = fmaxf(x, dpp_f<0x111, 0xf>(NI, x)); x = fmaxf(x, dpp_f<0x112, 0xf>(NI, x)); x = fmaxf(x, dpp_f<0x114, 0xf>(NI, x)); x = fmaxf(x, dpp_f<0x118, 0xf>(NI, x));
    x = fmaxf(x, dpp_f<0x142, 0xa>(NI, x)); x = fmaxf(x, dpp_f<0x143, 0xc>(NI, x));
    return x;
}
__device__ __forceinline__ bf16x8 pack_step(const f32x16& x, int s) {
    v4u p; p.x = cvtpk(x[8 * s + 0], x[8 * s + 1]); p.y = cvtpk(x[8 * s + 2], x[8 * s + 3]); p.z = cvtpk(x[8 * s + 4], x[8 * s + 5]); p.w = cvtpk(x[8 * s + 6], x[8 * s + 7]);
    return __builtin_bit_cast(bf16x8, p);
}
template <int B> __device__ __forceinline__ void qc_tile(const char* lds, const f32x16 (&C)[4], int r32, int hi, f32x16& o2) {
#pragma unroll
    for (int r = 0; r < 16; ++r) o2[r] = 0.f;
#pragma unroll
    for (int dt = 0; dt < 4; ++dt)
#pragma unroll
        for (int s = 0; s < 2; ++s) { const bf16x8 qf = *reinterpret_cast<const bf16x8*>(lds + QIMG + KSWZ(32 * B + r32, ((2 * dt + s) * 16 + hi * 8) * 2));
            o2 = __builtin_amdgcn_mfma_f32_32x32x16_bf16(qf, pack_step(C[dt], s), o2, 0, 0, 0); if (s == 1 && (dt & 1)) SBAR(); }
}
template <int B> __device__ __forceinline__ void pv_tile(const char* lds, int vbV, int r32, int hi, const f32x16& o2, f32x16& hout) {
    f32x16 o;
#pragma unroll
    for (int r = 0; r < 16; ++r) o[r] = 0.f;
    bf16x8 Vf[4];
    { const s16x4 l0 = tr_read<v_rd_off(0, 0, 0)>(vbV), h0 = tr_read<v_rd_off(0, 0, 1)>(vbV), l1 = tr_read<v_rd_off(0, 1, 0)>(vbV), h1 = tr_read<v_rd_off(0, 1, 1)>(vbV);
      s16x4 l2 = l0, h2 = h0, l3 = l1, h3 = h1;
      if (B == 1) { l2 = tr_read<v_rd_off(0, 2, 0)>(vbV); h2 = tr_read<v_rd_off(0, 2, 1)>(vbV); l3 = tr_read<v_rd_off(0, 3, 0)>(vbV); h3 = tr_read<v_rd_off(0, 3, 1)>(vbV); }
      asm volatile("s_waitcnt lgkmcnt(0)" ::: "memory"); SBAR();
      Vf[0] = PKF(l0, h0); Vf[1] = PKF(l1, h1); Vf[2] = PKF(l2, h2); Vf[3] = PKF(l3, h3); }
#pragma unroll
    for (int ks = 0; ks < (B == 0 ? 2 : 4); ++ks) { const bf16x8 pf = *reinterpret_cast<const bf16x8*>(lds + PIMG + KRSWZ(32 * B + r32, (ks * 16 + hi * 8) * 2));
        o = __builtin_amdgcn_mfma_f32_32x32x16_bf16(pf, Vf[ks], o, 0, 0, 0); }
    const float* RA = reinterpret_cast<const float*>(lds + RAOFF);
#pragma unroll
    for (int g = 0; g < 4; ++g) { const f32x4m ra = *reinterpret_cast<const f32x4m*>(RA + 32 * B + 8 * g + 4 * hi);
#pragma unroll
        for (int i = 0; i < 4; ++i) hout[4 * g + i] = o[4 * g + i] + ra[i] * o2[4 * g + i]; }
}
__device__ __forceinline__ void produce_p(char* lds, int W, int lane, int cur, const float* U, const float* Mx, const float* WI, const float* EN) {
    typedef float f32x4a __attribute__((ext_vector_type(4)));
    const int tl = lane & 15, sq = lane >> 4, t = 16 * W + tl;
    bf16x8 qf[4];
#pragma unroll
    for (int ks = 0; ks < 4; ++ks) qf[ks] = *reinterpret_cast<const bf16x8*>(lds + QIMG + KSWZ(t, (ks * 32 + sq * 8) * 2));
    f32x4a an = {0.f, 0.f, 0.f, 0.f};
#pragma unroll
    for (int ks = 0; ks < 4; ++ks) { const bf16x8 nf = *reinterpret_cast<const bf16x8*>(lds + NIMG + cur * 8192 + KSWZ(tl, (ks * 32 + sq * 8) * 2));
        an = __builtin_amdgcn_mfma_f32_16x16x32_bf16(nf, qf[ks], an, 0, 0, 0); }
    float qn = (sq == 0) ? an[0] : 0.f;
    qn += __shfl_xor(qn, 16); qn += __shfl_xor(qn, 32);
    f32x4a acc[4];
#pragma unroll
    for (int j = 0; j < 4; ++j) { acc[j] = (f32x4a){0.f, 0.f, 0.f, 0.f};
        if (j <= W) {
#pragma unroll
            for (int ks = 0; ks < 4; ++ks) { const bf16x8 kf = *reinterpret_cast<const bf16x8*>(lds + KIMG + KSWZ(16 * j + tl, (ks * 32 + sq * 8) * 2));
                acc[j] = __builtin_amdgcn_mfma_f32_16x16x32_bf16(kf, qf[ks], acc[j], 0, 0, 0); } } }
    const float Mt = Mx[t]; float rs = 0.f;
#pragma unroll
    for (int j = 0; j < 4; ++j) { const f32x4a u4 = *reinterpret_cast<const f32x4a*>(U + 16 * j + 4 * sq);
#pragma unroll
        for (int r = 0; r < 4; ++r) { const int s = 16 * j + 4 * sq + r; float w = __builtin_amdgcn_exp2f((u4[r] - Mt) * L2E); if (s > t) w = 0.f; acc[j][r] *= w; rs += acc[j][r]; } }
    rs += __shfl_xor(rs, 16); rs += __shfl_xor(rs, 32);
    const float wi = WI[t], den = rs + wi * qn, inv = __builtin_amdgcn_rcpf(fmaxf(fabsf(den), EN[t]));
    if (sq == 0) reinterpret_cast<float*>(lds + RAOFF)[t] = wi * inv;
#pragma unroll
    for (int j = 0; j < 4; ++j) { unsigned long long w8 = (unsigned long long)cvtpk(acc[j][0] * inv, acc[j][1] * inv) | ((unsigned long long)cvtpk(acc[j][2] * inv, acc[j][3] * inv) << 32);
        *reinterpret_cast<unsigned long long*>(lds + PIMG + KRSWZ(t, (16 * j + 4 * sq) * 2)) = w8; }
}

__device__ __forceinline__ void mlstm_unit(int seqbase, int dir, int h, const bf16* QKc, const bf16* Vg, const float* Gt, bf16* HM, char* lds) {
    const int tid = threadIdx.x, wid = __builtin_amdgcn_readfirstlane(tid >> 6), lane = tid & 63;
    float* wsp = (float*)(lds + WSCR + wid * 1024);
    float* U = wsp; float* Mx = wsp + 64; float* WI = wsp + 128; float* EN = wsp + 192;
    { const v4u z = {0u, 0u, 0u, 0u}; ((v4u*)(lds + NIMG))[tid] = z; ((v4u*)(lds + NIMG))[tid + 512] = z; }
    f32x16 C[4];
#pragma unroll
    for (int d = 0; d < 4; ++d)
#pragma unroll
        for (int r = 0; r < 16; ++r) C[d][r] = 0.f;
    float nreg = 0.f, m = 0.f;
    v4u sq0, sq1, sk0, sk1, sv0, sv1, sv2, sv3; float gi, gf;
#define ROWOF(c, j) (seqbase + (dir ? (SEQ - 1 - ((c) * 64 + (j))) : ((c) * 64 + (j))))
#define MLOAD(c) do { const long row_ = ROWOF(c, ss); const bf16* qp_ = QKc + row_ * 1024 + h * 128 + 16 * seg; const bf16* vp_ = Vg + toff<1024>((int)row_, h * 256 + 32 * seg); \
    sq0 = *(const GAS v4u*)qp_; sq1 = *(const GAS v4u*)(qp_ + 8); sk0 = *(const GAS v4u*)(qp_ + 512); sk1 = *(const GAS v4u*)(qp_ + 520); \
    sv0 = *(const GAS v4u*)vp_; sv1 = *(const GAS v4u*)(vp_ + 8); sv2 = *(const GAS v4u*)(vp_ + 16); sv3 = *(const GAS v4u*)(vp_ + 24); \
    const float* gp_ = Gt + (long)ROWOF(c, (int)(threadIdx.x & 63)) * 16 + 4 * dir + h; gi = gp_[0]; gf = gp_[8]; } while (0)
    float a, es;
#define SCALARS() do { const float b_ = scan_add(gf, lane), u_ = gi - b_, cm_ = scan_max(u_, lane), Mj_ = fmaxf(m, cm_); \
    const float M63_ = __builtin_bit_cast(float, __builtin_amdgcn_readlane(__builtin_bit_cast(int, Mj_), 63)), bl_ = __builtin_bit_cast(float, __builtin_amdgcn_readlane(__builtin_bit_cast(int, b_), 63)); const float e_ = fexp(u_ - M63_); a = fexp(m - M63_); \
    U[lane] = u_; Mx[lane] = Mj_; WI[lane] = fexp(m - Mj_); EN[lane] = fexp(-(b_ + Mj_)); es = __shfl(e_, 8 * wid + (lane >> 3)); m = bl_ + M63_; } while (0)
    { const int ss = tid >> 3, seg = tid & 7; MLOAD(0); }
    SCALARS();
#ifdef MLPROBE_SEG
#define MLSTAMP(k) do { if (blockIdx.x == 0 && threadIdx.x == 0) { const unsigned now_ = (unsigned)__builtin_amdgcn_s_memrealtime(); if ((k) == MLPROBE_SEG) mlp_t0 = now_; if ((k) == MLPROBE_SEG + 1) *(volatile unsigned*)(lds + 163840 - 64) += now_ - mlp_t0; } } while (0)
    unsigned mlp_t0 = 0; if (threadIdx.x == 0) *(volatile unsigned*)(lds + 163840 - 64) = 0u;
#else
#define MLSTAMP(k) do {} while (0)
#endif
    for (int c = 0; c < SEQ / 64; ++c) {
        int lane_o = lane; asm volatile("" : "+v"(lane_o));
        const int r32 = lane_o & 31, hi = lane_o >> 5, ss = 8 * wid + (lane_o >> 3), seg = lane_o & 7;
        const int vbK = (int)(uintptr_t)(lds + KAIMG) + v_rd_base(lane_o);
        const int vbV = (int)(uintptr_t)(lds + VIMG + (wid >> 2) * 16384) + v_rd_base(lane_o) + (wid & 3) * 512;
        MLSTAMP(0);
        __syncthreads();
        MLSTAMP(1);
        {
            *(v4u*)(lds + QIMG + KSWZ(ss, (16 * seg) * 2)) = sq0; *(v4u*)(lds + QIMG + KSWZ(ss, (16 * seg + 8) * 2)) = sq1;
            *(v4u*)(lds + KIMG + KSWZ(ss, (16 * seg) * 2)) = sk0; *(v4u*)(lds + KIMG + KSWZ(ss, (16 * seg + 8) * 2)) = sk1;
        }
        MLSTAMP(1);
        __syncthreads();
        MLSTAMP(2);
        {
            f32x4 a0, a1, b0, b1; unpk8(sk0, a0, a1); unpk8(sk1, b0, b1);
            a0 *= es; a1 *= es; b0 *= es; b1 *= es;
            *(v4u*)(lds + KAIMG + v_st(ss, 16 * seg)) = pk8g(a0, b0); *(v4u*)(lds + KAIMG + v_st(ss, 16 * seg + 8)) = pk8g(a1, b1);
            char* vi = lds + VIMG + (seg >> 2) * 16384; const int vc = 32 * (seg & 3);
            *(v4u*)(vi + v_st(ss, vc)) = sv0; *(v4u*)(vi + v_st(ss, vc + 8)) = sv1; *(v4u*)(vi + v_st(ss, vc + 16)) = sv2; *(v4u*)(vi + v_st(ss, vc + 24)) = sv3;
        }
        if (c + 1 < SEQ / 64) MLOAD(c + 1);
        const float a_c = a;
        f32x16 o2a, o2b;
        if (wid < 4) produce_p(lds, wid, lane_o, c & 1, U, Mx, WI, EN);
        else { qc_tile<0>(lds, C, r32, hi, o2a); SBAR(); qc_tile<1>(lds, C, r32, hi, o2b); SBAR(); }
        MLSTAMP(3);
        __syncthreads();
        MLSTAMP(4);
        if (wid < 4) { qc_tile<0>(lds, C, r32, hi, o2a); SBAR(); qc_tile<1>(lds, C, r32, hi, o2b); SBAR(); }
        {
            const int rstep = dir ? -1024 : 1024;
            bf16* hp0 = HM + (long)ROWOF(c, 0) * 1024 + h * 256 + 32 * wid;
            int loff = r32 + 4 * hi * rstep;
            asm volatile("" : "+v"(loff));
            f32x16 hv;
            pv_tile<0>(lds, vbV, r32, hi, o2a, hv);
#pragma unroll
            for (int r = 0; r < 16; ++r) (hp0 + ((r & 3) + 8 * (r >> 2)) * rstep)[loff] = (bf16)(cvtpk(hv[r], 0.f) & 0xffffu);
            SBAR();
            pv_tile<1>(lds, vbV, r32, hi, o2b, hv);
#pragma unroll
            for (int r = 0; r < 16; ++r) (hp0 + (32 + (r & 3) + 8 * (r >> 2)) * rstep)[loff] = (bf16)(cvtpk(hv[r], 0.f) & 0xffffu);
            SBAR();
        }
        MLSTAMP(5);
        float nsum = 0.f;
        bf16x8 Vf[4];
        { const s16x4 l0 = tr_read<v_rd_off(0, 0, 0)>(vbV), h0 = tr_read<v_rd_off(0, 0, 1)>(vbV), l1 = tr_read<v_rd_off(0, 1, 0)>(vbV), h1 = tr_read<v_rd_off(0, 1, 1)>(vbV);
          const s16x4 l2 = tr_read<v_rd_off(0, 2, 0)>(vbV), h2 = tr_read<v_rd_off(0, 2, 1)>(vbV), l3 = tr_read<v_rd_off(0, 3, 0)>(vbV), h3 = tr_read<v_rd_off(0, 3, 1)>(vbV);
          asm volatile("s_waitcnt lgkmcnt(0)" ::: "memory"); SBAR();
          Vf[0] = PKF(l0, h0); Vf[1] = PKF(l1, h1); Vf[2] = PKF(l2, h2); Vf[3] = PKF(l3, h3); }
#define CUPD(DT) do { \
        bf16x8 f0_, f1_, f2_, f3_; \
        { const s16x4 l0 = tr_read<v_rd_off(DT, 0, 0)>(vbK), h0 = tr_read<v_rd_off(DT, 0, 1)>(vbK), l1 = tr_read<v_rd_off(DT, 1, 0)>(vbK), h1 = tr_read<v_rd_off(DT, 1, 1)>(vbK); \
          const s16x4 l2 = tr_read<v_rd_off(DT, 2, 0)>(vbK), h2 = tr_read<v_rd_off(DT, 2, 1)>(vbK), l3 = tr_read<v_rd_off(DT, 3, 0)>(vbK), h3 = tr_read<v_rd_off(DT, 3, 1)>(vbK); \
          asm volatile("s_waitcnt lgkmcnt(0)" ::: "memory"); SBAR(); \
          f0_ = PKF(l0, h0); f1_ = PKF(l1, h1); f2_ = PKF(l2, h2); f3_ = PKF(l3, h3); } \
        _Pragma("unroll") for (int r = 0; r < 16; ++r) C[DT][r] *= a_c; \
        C[DT] = __builtin_amdgcn_mfma_f32_32x32x16_bf16(f0_, Vf[0], C[DT], 0, 0, 0); C[DT] = __builtin_amdgcn_mfma_f32_32x32x16_bf16(f1_, Vf[1], C[DT], 0, 0, 0); \
        C[DT] = __builtin_amdgcn_mfma_f32_32x32x16_bf16(f2_, Vf[2], C[DT], 0, 0, 0); C[DT] = __builtin_amdgcn_mfma_f32_32x32x16_bf16(f3_, Vf[3], C[DT], 0, 0, 0); \
        if (wid == 4 + DT) { const v4u q0 = __builtin_bit_cast(v4u, f0_), q1 = __builtin_bit_cast(v4u, f1_), q2 = __builtin_bit_cast(v4u, f2_), q3 = __builtin_bit_cast(v4u, f3_); \
            _Pragma("unroll") for (int i = 0; i < 4; ++i) nsum += (bflo(q0[i]) + bfhi(q0[i])) + (bflo(q1[i]) + bfhi(q1[i])) + (bflo(q2[i]) + bfhi(q2[i])) + (bflo(q3[i]) + bfhi(q3[i])); } \
        } while (0)
        CUPD(0); CUPD(1); CUPD(2); CUPD(3);
        if (wid >= 4) {
            nsum = swap_add(nsum); nreg = a_c * nreg + nsum;
            if (hi == 0) { const int p = sig16(32 * (wid - 4) + r32); *(bf16*)(lds + NIMG + ((c + 1) & 1) * 8192 + KSWZ(0, p * 2)) = (bf16)(cvtpk(nreg, 0.f) & 0xffffu); }
        }
        MLSTAMP(6);
        if (c + 1 < SEQ / 64) SCALARS();
        MLSTAMP(7);
    }
#undef CUPD
#undef MLOAD
#undef SCALARS
#undef ROWOF
}
}
#ifndef ALIGN_EPI_FLAG
#define ALIGN_EPI_FLAG true
#endif
#ifndef GRP_TEST
#define GRP_TEST 4
#endif
#ifndef SP2_FLAG
#define SP2_FLAG true
#endif

#define EPI_ARGS int row, int col, f32x4 a0, f32x4 a1, f32x4 b0, f32x4 b1, int pn, int wc, int fq, float pre, const Ld& ld
#define NO_LD typedef pg8::NoLd Ld; static constexpr int GROUP = 4; __device__ __forceinline__ Ld load(int, int, int) const { return Ld{}; }
#define NO_PRE static constexpr bool HAS_PRE = false; __device__ __forceinline__ float pre(int, int) const { return 0.f; }
#define NO_FIN __device__ __forceinline__ void finish(int, int, int, int, int, int) const {}
#ifndef USE_RELAX
#define NSTV(n) 0
#else
#define NSTV(n) (n)
#endif
#ifdef NT_STORES
__device__ __forceinline__ void st8(bf16* p, f32x4 a, f32x4 b) { __builtin_nontemporal_store(pk8g(a, b), (GAS v4u*)p); }
#else
__device__ __forceinline__ void st8(bf16* p, f32x4 a, f32x4 b) { *(GAS v4u*)p = pk8g(a, b); }
#endif
__device__ __forceinline__ void ld8(const bf16* p, f32x4& a, f32x4& b) { unpk8(*(const GAS v4u*)p, a, b); }
__device__ __forceinline__ float sq8(f32x4 a, f32x4 b) { return (a[0] * a[0] + a[1] * a[1]) + (a[2] * a[2] + a[3] * a[3]) + (b[0] * b[0] + b[1] * b[1]) + (b[2] * b[2] + b[3] * b[3]); }
__device__ __forceinline__ void rope8(const f32x2g* tab, int pos, int i0, f32x4& a0, f32x4& a1) {
    const f32x4 c01 = *(const GAS f32x4*)(tab + pos * 32 + i0), c23 = *(const GAS f32x4*)(tab + pos * 32 + i0 + 2);
    f32x4 r0, r1;
    r0[0] = a0[0] * c01[0] - a0[1] * c01[1]; r0[1] = a0[0] * c01[1] + a0[1] * c01[0];
    r0[2] = a0[2] * c01[2] - a0[3] * c01[3]; r0[3] = a0[2] * c01[3] + a0[3] * c01[2];
    r1[0] = a1[0] * c23[0] - a1[1] * c23[1]; r1[1] = a1[0] * c23[1] + a1[1] * c23[0];
    r1[2] = a1[2] * c23[2] - a1[3] * c23[3]; r1[3] = a1[2] * c23[3] + a1[3] * c23[2];
    a0 = r0; a1 = r1;
}
__device__ __forceinline__ void rope8v(f32x4 c01, f32x4 c23, f32x4& a0, f32x4& a1) {
    f32x4 r0, r1;
    r0[0] = a0[0] * c01[0] - a0[1] * c01[1]; r0[1] = a0[0] * c01[1] + a0[1] * c01[0];
    r0[2] = a0[2] * c01[2] - a0[3] * c01[3]; r0[3] = a0[2] * c01[3] + a0[3] * c01[2];
    r1[0] = a1[0] * c23[0] - a1[1] * c23[1]; r1[1] = a1[0] * c23[1] + a1[1] * c23[0];
    r1[2] = a1[2] * c23[2] - a1[3] * c23[3]; r1[3] = a1[2] * c23[3] + a1[3] * c23[2];
    a0 = r0; a1 = r1;
}
__device__ __forceinline__ float log_sigmoid(float x) { return fminf(x, 0.f) - logf(1.f + expf(-fabsf(x))); }

struct FIn {
    bf16 *qkraw, *vv, *osig, *gm, *cq, *ckv, *kr; float *gates, *ssqq, *ssqkv; const f32x2g* tab; const float* bgate;
    NO_FIN static constexpr int NST = NSTV(0); static constexpr int FENCE = 2; NO_PRE
    static constexpr int GROUP = 4;
    struct Ld { f32x4 c01, c23; };
    __device__ __forceinline__ Ld load(int row, int col, int pn) const { Ld l; l.c01 = (f32x4){0.f, 0.f, 0.f, 0.f}; l.c23 = l.c01;
        if (pn == 22) { const int j = col - 5632;
            if (j < 64) { const f32x2g* t = tab + (row & (SEQ - 1)) * 32 + (j >> 1); l.c01 = *(const GAS f32x4*)t; l.c23 = *(const GAS f32x4*)(t + 2); }
            else if (j < 80) { l.c01 = *(const GAS f32x4*)(bgate + (j - 64)); l.c23 = *(const GAS f32x4*)(bgate + (j - 64) + 4); } }
        return l; }
    __device__ __forceinline__ void operator()(EPI_ARGS) const {
        if (pn < 8) { bf16* t_ = (pn < 4 ? qkraw : vv); st8(t_ + toff<1024>(row, col & 1023), a0, a1); st8(t_ + toff<1024>(row, (col & 1023) + 128), b0, b1); }
        else if (pn < 12) { st8(osig + toff<1024>(row, col - 2048), sig4(a0), sig4(a1)); st8(osig + toff<1024>(row, col - 2048 + 128), sig4(b0), sig4(b1)); }
        else if (pn < 20) { st8(gm + toff<2048>(row, col - 3072), sig4(a0), sig4(a1)); st8(gm + toff<2048>(row, col - 3072 + 128), sig4(b0), sig4(b1)); }
        else if (pn < 22) { bf16* t_ = (pn == 20 ? cq : ckv); st8(t_ + toff<256>(row, col & 255), a0, a1); st8(t_ + toff<256>(row, (col & 255) + 128), b0, b1);
            float s = sq8(a0, a1) + sq8(b0, b1); s += __shfl_xor(s, 16); s += __shfl_xor(s, 32);
            if (fq == 0) (pn == 20 ? ssqq : ssqkv)[(size_t)row * 4 + wc] = s; }
        else { const int j = col - 5632;
            if (j < 64) { rope8v(ld.c01, ld.c23, a0, a1); st8(kr + (size_t)row * 64 + j, a0, a1); }
            else if (j < 80) { a0 += ld.c01; a1 += ld.c23;
                if (j == 72) {
#pragma unroll
                    for (int k = 0; k < 4; ++k) { a0[k] = log_sigmoid(a0[k]); a1[k] = log_sigmoid(a1[k]); } }
                float* gp = gates + (size_t)row * 16 + (j - 64); *(GAS f32x4*)gp = a0; *(GAS f32x4*)(gp + 4) = a1; }
        }
    }
};
struct FQ {
    bf16 *qn, *qr; const float* ssq; const f32x2g* tab;
    NO_LD NO_FIN static constexpr int NST = NSTV(16); static constexpr int FENCE = 2;
    static constexpr bool HAS_PRE = true; __device__ __forceinline__ float pre(int row, int) const { const f32x4 s4 = *(const GAS f32x4*)(ssq + (size_t)row * 4); return 1.0f / sqrtf(((s4[0] + s4[1]) + (s4[2] + s4[3])) * (1.f / 256.f) + EPS); }
    __device__ __forceinline__ void operator()(EPI_ARGS) const {
        const float rstd = pre;
        a0 *= rstd; a1 *= rstd; b0 *= rstd; b1 *= rstd;
        if (pn < 4) { st8(qn + toff<1024>(row, col), a0, a1); st8(qn + toff<1024>(row, col + 128), b0, b1); }
        else { const int c = col - 1024, i0 = (c & 63) >> 1, pos = row & (SEQ - 1); rope8(tab, pos, i0, a0, a1); rope8(tab, pos, i0, b0, b1);
            st8(qr + toff<512>(row, c), a0, a1); st8(qr + toff<512>(row, c + 128), b0, b1); }
    }
};
struct FKV {
    bf16 *kn, *va; const float* ssq;
    NO_LD NO_FIN static constexpr int NST = NSTV(16); static constexpr int FENCE = 2;
    static constexpr bool HAS_PRE = true; __device__ __forceinline__ float pre(int row, int) const { const f32x4 s4 = *(const GAS f32x4*)(ssq + (size_t)row * 4); return 1.0f / sqrtf(((s4[0] + s4[1]) + (s4[2] + s4[3])) * (1.f / 256.f) + EPS); }
    __device__ __forceinline__ void operator()(EPI_ARGS) const {
        const float rstd = pre;
        a0 *= rstd; a1 *= rstd; b0 *= rstd; b1 *= rstd;
        bf16* t_ = (pn < 4 ? kn : va); st8(t_ + toff<1024>(row, col & 1023), a0, a1); st8(t_ + toff<1024>(row, (col & 1023) + 128), b0, b1);
    }
};
struct FE1 {
    bf16* t; const bf16* gm;
    NO_FIN static constexpr int NST = NSTV(16); static constexpr int FENCE = 4, GROUP = 4; NO_PRE
    struct Ld { v4u g0, g1; };
    __device__ __forceinline__ Ld load(int row, int col, int) const { Ld l; l.g0 = *(const GAS v4u*)(gm + toff<2048>(row, col)); l.g1 = *(const GAS v4u*)(gm + toff<2048>(row, col + 128)); return l; }
    __device__ __forceinline__ void operator()(EPI_ARGS) const {
        f32x4 g0, g1, g2, g3; unpk8(ld.g0, g0, g1); unpk8(ld.g1, g2, g3);
        st8(t + toff<1024>(row, col), a0 * g0, a1 * g1); st8(t + toff<1024>(row, col + 128), b0 * g2, b1 * g3);
    }
};
struct FPlain { bf16* o;
    NO_LD NO_FIN static constexpr int NST = NSTV(16); static constexpr int FENCE = 2; NO_PRE
    __device__ __forceinline__ void operator()(EPI_ARGS) const { st8(o + toff<1024>(row, col), a0, a1); st8(o + toff<1024>(row, col + 128), b0, b1); }
};
struct FNone { bf16* o;
    NO_LD NO_FIN static constexpr int NST = NSTV(0); static constexpr int FENCE = 2; NO_PRE
    __device__ __forceinline__ void operator()(EPI_ARGS) const { asm volatile("" :: "v"(a0), "v"(a1), "v"(b0), "v"(b1)); }
};
struct FLin { bf16* o;
    NO_LD NO_FIN static constexpr int NST = NSTV(16); static constexpr int FENCE = 2; NO_PRE
    __device__ __forceinline__ void operator()(EPI_ARGS) const { const int lane = lane_id(), wv = (int)(threadIdx.x >> 6);
        bf16* p = o + ((size_t)(row >> 8) * 4 + pn) * 65536 + (size_t)wv * 8192 + (size_t)((row >> 4) & 7) * 1024 + lane * 8; st8(p, a0, a1); st8(p + 512, b0, b1); }
};
struct FE2 {
    bf16* mg; const bf16* t; const bf16* gm;
    NO_FIN static constexpr int NST = NSTV(16); static constexpr int FENCE = 4, GROUP = 4; NO_PRE
    struct Ld { v4u g0, g1, t0, t1; };
    __device__ __forceinline__ Ld load(int row, int col, int) const {
        Ld l; l.g0 = *(const GAS v4u*)(gm + toff<2048>(row, 1024 + col)); l.g1 = *(const GAS v4u*)(gm + toff<2048>(row, 1024 + col + 128)); l.t0 = *(const GAS v4u*)(t + toff<1024>(row, col)); l.t1 = *(const GAS v4u*)(t + toff<1024>(row, col + 128)); return l; }
    __device__ __forceinline__ void operator()(EPI_ARGS) const {
        f32x4 g0, g1, g2, g3, t0, t1, t2, t3; unpk8(ld.g0, g0, g1); unpk8(ld.g1, g2, g3); unpk8(ld.t0, t0, t1); unpk8(ld.t1, t2, t3);
        st8(mg + toff<1024>(row, col), t0 + a0 * g0, t1 + a1 * g1); st8(mg + toff<1024>(row, col + 128), t2 + b0 * g2, t3 + b1 * g3);
    }
};
struct FE12 {
    bf16* mg; const bf16* gm;
    struct Ld { v4u m0, m1, a0, a1; };
    __device__ __forceinline__ Ld load(int row, int col, int gi) const { Ld l; l.m0 = (v4u){0u, 0u, 0u, 0u}; l.m1 = l.m0;
        if (gi == 0) { l.m0 = *(const GAS v4u*)(gm + toff<2048>(row, col)); l.m1 = *(const GAS v4u*)(gm + toff<2048>(row, col + 128)); }
        l.a0 = *(const GAS v4u*)(gm + toff<2048>(row, 1024 + col)); l.a1 = *(const GAS v4u*)(gm + toff<2048>(row, 1024 + col + 128)); return l; }
    __device__ __forceinline__ void apply(int row, int col, f32x4& a0, f32x4& a1, f32x4& b0, f32x4& b1, int gi, const Ld& ld) const {
        f32x4 ga0, ga1, ga2, ga3; unpk8(ld.a0, ga0, ga1); unpk8(ld.a1, ga2, ga3);
#pragma unroll
        for (int k = 0; k < 4; ++k) { ga0[k] = fmaxf(ga0[k], 1e-20f); ga1[k] = fmaxf(ga1[k], 1e-20f); ga2[k] = fmaxf(ga2[k], 1e-20f); ga3[k] = fmaxf(ga3[k], 1e-20f); }
        if (gi == 0) { f32x4 gm0, gm1, gm2, gm3; unpk8(ld.m0, gm0, gm1); unpk8(ld.m1, gm2, gm3);
#pragma unroll
            for (int k = 0; k < 4; ++k) { a0[k] *= gm0[k] * __builtin_amdgcn_rcpf(ga0[k]); a1[k] *= gm1[k] * __builtin_amdgcn_rcpf(ga1[k]); b0[k] *= gm2[k] * __builtin_amdgcn_rcpf(ga2[k]); b1[k] *= gm3[k] * __builtin_amdgcn_rcpf(ga3[k]); } }
        else { st8(mg + toff<1024>(row, col), a0 * ga0, a1 * ga1); st8(mg + toff<1024>(row, col + 128), b0 * ga2, b1 * ga3); }
    }
};
struct FE3 {
    const float *xp, *xs; bf16* xb; float* ssq; LAS float* tab;
    static constexpr int NST = NSTV(16); static constexpr int FENCE = 4, GROUP = GRP_TEST; NO_PRE
    struct Ld { f32x4 x0, x1, x2, x3; };
    __device__ __forceinline__ Ld load(int row, int col, int) const { const float* xr = (row < MP ? xp + (size_t)row * DM : xs + (size_t)(row - MP) * DM) + col;
        Ld l; l.x0 = *(const GAS f32x4*)xr; l.x1 = *(const GAS f32x4*)(xr + 4); l.x2 = *(const GAS f32x4*)(xr + 128); l.x3 = *(const GAS f32x4*)(xr + 132); return l; }
    __device__ __forceinline__ void operator()(EPI_ARGS) const {
        a0 += ld.x0; a1 += ld.x1; b0 += ld.x2; b1 += ld.x3;
        st8(xb + toff<1024>(row, col), a0, a1); st8(xb + toff<1024>(row, col + 128), b0, b1);
        float s = sq8(a0, a1) + sq8(b0, b1); s += __shfl_xor(s, 16); s += __shfl_xor(s, 32);
        if (fq == 0) tab[(row & 255) * 4 + wc] = s;
    }
    __device__ __forceinline__ void finish(int pm, int pn, int wr, int wc, int fr, int fq) const {
        asm volatile("s_waitcnt lgkmcnt(0)" ::: "memory"); __builtin_amdgcn_s_barrier(); asm volatile("" ::: "memory");
        if (wc == 0) {
#pragma unroll
            for (int h = 0; h < 2; ++h) { const int rl = 128 * h + 64 * wr + 16 * fq + fr; const f32x4 t4 = *(const LAS f32x4*)(tab + rl * 4);
                ssq[(size_t)(pm * 256 + rl) * 4 + pn] = (t4[0] + t4[1]) + (t4[2] + t4[3]); }
        }
        asm volatile("s_waitcnt lgkmcnt(0)" ::: "memory"); __builtin_amdgcn_s_barrier(); asm volatile("" ::: "memory");
    }
};
struct FF1 {
    bf16* gu; const float* ssq;
    NO_LD NO_FIN static constexpr int NST = NSTV(8); static constexpr int FENCE = 2;
    static constexpr bool HAS_PRE = true; __device__ __forceinline__ float pre(int row, int) const { const f32x4 s4 = *(const GAS f32x4*)(ssq + (size_t)row * 4); return 1.0f / sqrtf(((s4[0] + s4[1]) + (s4[2] + s4[3])) * (1.f / DM) + EPS); }
    __device__ __forceinline__ void operator()(EPI_ARGS) const {
        const float rstd = pre;
        f32x4 r0, r1;
#pragma unroll
        for (int k = 0; k < 4; ++k) { const float g0 = a0[k] * rstd, g1 = a1[k] * rstd; r0[k] = g0 * fsigmoid(g0) * (b0[k] * rstd); r1[k] = g1 * fsigmoid(g1) * (b1[k] * rstd); }
        st8(gu + toff<DFF>(row, col - 128 * pn), r0, r1);
    }
};
struct FF2 {
    const bf16* x1; bf16* xb;
    NO_FIN static constexpr int NST = NSTV(16); static constexpr int FENCE = 4, GROUP = 4; NO_PRE
    struct Ld { v4u r0, r1; };
    __device__ __forceinline__ Ld load(int row, int col, int) const { Ld l; l.r0 = *(const GAS v4u*)(x1 + toff<1024>(row, col)); l.r1 = *(const GAS v4u*)(x1 + toff<1024>(row, col + 128)); return l; }
    __device__ __forceinline__ void operator()(EPI_ARGS) const {
        f32x4 r0, r1, r2, r3; unpk8(ld.r0, r0, r1); unpk8(ld.r1, r2, r3);
        st8(xb + toff<1024>(row, col), a0 + r0, a1 + r1); st8(xb + toff<1024>(row, col + 128), b0 + r2, b1 + r3);
    }
};
struct FG1 {
    bf16* out; const bf16* x2; const bf16* y2;
    NO_FIN static constexpr int NST = NSTV(16); static constexpr int FENCE = 4, GROUP = GRP_TEST; NO_PRE
    struct Ld { v4u y0, y1, r0, r1; };
    __device__ __forceinline__ Ld load(int row, int col, int) const {
        Ld l; l.y0 = *(const GAS v4u*)(y2 + toff<1024>(row, col)); l.y1 = *(const GAS v4u*)(y2 + toff<1024>(row, col + 128)); l.r0 = *(const GAS v4u*)(x2 + toff<1024>(row, col)); l.r1 = *(const GAS v4u*)(x2 + toff<1024>(row, col + 128));
        return l; }
    __device__ __forceinline__ void operator()(EPI_ARGS) const {
        f32x4 y0, y1, y2v, y3, r0, r1, r2, r3; unpk8(ld.y0, y0, y1); unpk8(ld.y1, y2v, y3); unpk8(ld.r0, r0, r1); unpk8(ld.r1, r2, r3);
        st8(out + toff<1024>(row, col), r0 + sig4(a0) * y0, r1 + sig4(a1) * y1); st8(out + toff<1024>(row, col + 128), r2 + sig4(b0) * y2v, r3 + sig4(b1) * y3);
    }
};
template <class F, int PFA = 0, int LPR = 16, bool ATILED = true> __device__ __forceinline__ void run_gemm(LAS unsigned char* lds, unsigned* dumpw, const bf16* A, const bf16* Bt, int N, int K, int G, const F& f, int skew_ticks = 0, bool probe_this = false, int rev = 0) {
    if (skew_ticks) {
        const unsigned long long t0 = __builtin_amdgcn_s_memrealtime(), want = (unsigned long long)(((blockIdx.x >> 3) & 3) * skew_ticks);
        while (__builtin_amdgcn_s_memrealtime() - t0 < want) __builtin_amdgcn_s_sleep(16);
    }
    asm volatile("" : "+s"(K));
    pg8::Gemm g{A, Bt, M, N, K, nullptr, nullptr}; pg8::StaticOrder S; S.init(M, N, G, (int)blockIdx.x, rev); S.dump = dumpw;
#ifdef PROBE_EPI
    pg8::Epi8<F> E{f, {0.f, 0.f, 0.f, 0.f, 0.f, 0.f, 0.f, 0.f}, -1, probe_this, (volatile LAS unsigned*)(lds + MISC_OFF + 64)};
#else
    pg8::Epi8<F> E{f, {0.f, 0.f, 0.f, 0.f, 0.f, 0.f, 0.f, 0.f}, -1};
#endif
    pg8::gemm_phase<pg8::Epi8<F>, pg8::StaticOrder, ALIGN_EPI_FLAG, SP2_FLAG, PFA, LPR, ATILED>(lds, g, S, E);
}

template <class F> __device__ __forceinline__ void run_gemm_pair(LAS unsigned char* lds, unsigned* dumpw, const bf16* A0, const bf16* B0, const bf16* A1, const bf16* B1, int N, int K, int G, const F& f) {
    asm volatile("" : "+s"(K));
    pg8::Gemm g{A0, B0, M, N, K, A1, B1}; pg8::PairOrder S; S.S.init(M, N, G, (int)blockIdx.x, 0); S.dump = dumpw;
    pg8::EpiPair<F> E{f};
    pg8::gemm_phase<pg8::EpiPair<F>, pg8::PairOrder, ALIGN_EPI_FLAG, SP2_FLAG, 0, 16, true, true>(lds, g, S, E);
}

#ifndef MK_N_LAUNCHES
#define MK_N_LAUNCHES 1
#endif
constexpr int N_PHASES = 14;
#define DUMPW ((unsigned*)(ws + WS_CTL + 524288))
#ifdef USE_PFA
#define PF1 1
#define PF2 2
#define PF6 6
#else
#define PF1 0
#define PF2 0
#define PF6 0
#endif
#ifdef TILED_X2
#define TILED_X2_FLAG true
#else
#define TILED_X2_FLAG false
#endif
#ifndef REV_G1
#define REV_G1 0
#endif
#ifndef SKEWBIG
#define SKEWBIG 0
#endif
#ifndef SKEW
#define SKEW 0
#endif
struct Args { const float* in[23]; float* out; unsigned char* ws; int ph_lo, ph_hi; };
__device__ __forceinline__ const float* in_ptr(int k) {
    typedef const float* __attribute__((address_space(4))) const* kaptr_t;
    kaptr_t ka = (kaptr_t)__builtin_amdgcn_kernarg_segment_ptr(); asm volatile("" : "+s"(ka));
    return ka[k];
}
__global__ void __launch_bounds__(NWAVES * 64, 2) fwd_kernel(Args args) {
    extern __shared__ __attribute__((aligned(16))) unsigned char lds[];
    LAS unsigned char* L = (LAS unsigned char*)lds;
    volatile LAS unsigned* MISC = (volatile LAS unsigned*)(L + MISC_OFF);
    const int tid = threadIdx.x, wave = __builtin_amdgcn_readfirstlane(tid >> 6);
    const int G = gridDim.x, bx = blockIdx.x, vcu = (G % 8 == 0) ? (bx % 8) * (G / 8) + bx / 8 : bx;
    const int gw = vcu * NWAVES + wave, NGW = G * NWAVES;
    unsigned char* ws = args.ws;
    for (int u = tid; u < (LDS_BYTES - PHASE_LDS) / 4; u += NWAVES * 64) ((LAS unsigned*)(L + PHASE_LDS))[u] = 0u;
    static_assert(att::ATT_LDS <= PHASE_LDS && ml::ML_LDS <= PHASE_LDS, "phase scratch");
    __syncthreads();
    XcdBarrier bar = xcd_barrier_post((unsigned*)(ws + WS_CTL) + CW_BAR, MISC + 8);
    bf16 *R1 = (bf16*)(ws + WS_R1), *R2 = (bf16*)(ws + WS_R2), *R3 = (bf16*)(ws + WS_R3), *R4 = (bf16*)(ws + WS_R4), *R5 = (bf16*)(ws + WS_R5);
    bf16 *CQ = (bf16*)(ws + WS_CQ), *CKV = (bf16*)(ws + WS_CKV), *KR = (bf16*)(ws + WS_KR), *PB = (bf16*)(ws + WS_PB);
    float *GT = (float*)(ws + WS_G), *SSQQ = (float*)(ws + WS_SSQQ), *SSQKV = (float*)(ws + WS_SSQKV), *SSQ1 = (float*)(ws + WS_SSQ1);
    const f32x2g* TAB = (const f32x2g*)(ws + WS_TAB);
    bf16* GM = (bf16*)args.out;
    const int PH_LO = args.ph_lo, PH_HI = args.ph_hi;
#ifdef ONLY_PHASE
#define PH(k) if ((k) == ONLY_PHASE)
#else
#define PH(k) if (PH_LO <= (k) && (k) < PH_HI)
#endif
#ifdef PROBE_LO
    unsigned long long pt0 = 0, pt1 = 0;
#define SEAM(k) do { if (PH_LO <= (k) && (k) + 1 < PH_HI) xcd_barrier(bar); if ((k) + 1 == PROBE_LO) pt0 = __builtin_amdgcn_s_memrealtime(); if ((k) + 1 == PROBE_HI) pt1 = __builtin_amdgcn_s_memrealtime(); } while (0)
#else
#define SEAM(k) do { if (PH_LO <= (k) && (k) + 1 < PH_HI) xcd_barrier(bar); } while (0)
#endif

    PH(0) { p0_prologue(ws, L, vcu, G, wave, lane_id(), tid); } SEAM(0);
    PH(1) { FIn f{R2, R3, R4, GM, CQ, CKV, KR, GT, SSQQ, SSQKV, TAB, in_ptr(6)}; run_gemm(L, DUMPW, R1, (const bf16*)(ws + WS_WIN), NIN, 1024, G, f, SKEWBIG); } SEAM(1);
    PH(2) { t1_conv(R2, R1, in_ptr(7), gw, NGW, lane_id()); } SEAM(2);
    PH(3) { if (vcu < NSEQ * 8) { const int sq = vcu >> 3, dir = (vcu >> 2) & 1, hh = vcu & 3; ml::mlstm_unit(sq * SEQ, dir, hh, R1, R3, GT, dir ? R5 : R2, (char*)lds); } } SEAM(3);
    PH(4) { t2_combine(R2, R5, R4, in_ptr(8), gw, NGW, lane_id()); } SEAM(4);
    PH(5) { { FQ f{R1, R2, SSQQ, TAB}; run_gemm<FQ, PF1, 4>(L, DUMPW, CQ, (const bf16*)(ws + WS_WUQ), 1536, 256, G, f); }
            { FKV f{R3, R5, SSQKV}; run_gemm<FKV, PF1, 4>(L, DUMPW, CKV, (const bf16*)(ws + WS_WUKV), 2048, 256, G, f); } } SEAM(5);
    PH(6) { for (int g = vcu; g < NSEQ * 8 * 16; g += G) {
                const int bh = g >> 4, qb = g & 15, sq = bh >> 3, hh = bh & 7;
                const int g2 = g + G, bh2 = g2 >> 4;
                att::attn_unit(R1, R2, R3, KR, R5, R1, sq * SEQ, qb, hh, (char*)lds, (bh2 >> 3) * SEQ, g2 < NSEQ * 8 * 16 ? (g2 & 15) : -1, bh2 & 7); } } SEAM(6);
#ifdef NO_PAIR
    PH(7) { { FE1 f{R2, GM}; run_gemm<FE1, PF2, 16>(L, DUMPW, R4, (const bf16*)(ws + WS_WMO), 1024, 1024, G, f, SKEW); }
#ifdef PROBE_Y2
            pt0 = __builtin_amdgcn_s_memrealtime();
#endif
            { FPlain f{R5}; run_gemm<FPlain, PF1, 4>(L, DUMPW, PB, (const bf16*)(ws + WS_WPLE), 1024, 256, G, f); } } SEAM(7);
#ifdef PROBE_Y2
    pt1 = __builtin_amdgcn_s_memrealtime();
#endif
    PH(8) { FE2 f{R3, R2, GM}; run_gemm<FE2, PF2, 16>(L, DUMPW, R1, (const bf16*)(ws + WS_WAO), 1024, 1024, G, f, SKEW); } SEAM(8);
#else
    PH(7) { { FE12 f{R3, GM}; run_gemm_pair(L, DUMPW, R4, (const bf16*)(ws + WS_WMO), R1, (const bf16*)(ws + WS_WAO), 1024, 1024, G, f); }
            { FPlain f{R5}; run_gemm<FPlain, PF1, 4>(L, DUMPW, PB, (const bf16*)(ws + WS_WPLE), 1024, 256, G, f); } } SEAM(7);
#endif
    PH(9) { FE3 f{in_ptr(0), in_ptr(1), R1, SSQ1, (LAS float*)(L + RING_BYTES)}; run_gemm<FE3, PF2, 16>(L, DUMPW, R3, (const bf16*)(ws + WS_WOUT), 1024, 1024, G, f, SKEW); } SEAM(9);
    PH(10) { FF1 f{R2, SSQ1}; run_gemm(L, DUMPW, R1, (const bf16*)(ws + WS_WGU), NGU, 1024, G, f, SKEWBIG); } SEAM(10);
    PH(11) { FF2 f{R1, (bf16*)args.out}; run_gemm<FF2, PF6, 44>(L, DUMPW, R2, (const bf16*)(ws + WS_WDN), 1024, DFF, G, f, SKEW); } SEAM(11);
    PH(12) { FG1 f{R2, (const bf16*)args.out, R5}; run_gemm<FG1, PF2, 16>(L, DUMPW, (const bf16*)args.out, (const bf16*)(ws + WS_WPG), 1024, 1024, G, f, SKEW, true, REV_G1); } SEAM(12);
#ifdef PROBE_G1_TWICE
    xcd_barrier(bar); pt0 = __builtin_amdgcn_s_memrealtime();
    { FG1 f{R2, (const bf16*)args.out, R5}; run_gemm<FG1, PF2, 16>(L, DUMPW, (const bf16*)args.out, (const bf16*)(ws + WS_WPG), 1024, 1024, G, f, SKEW, false, REV_G1); }
    xcd_barrier(bar); pt1 = __builtin_amdgcn_s_memrealtime();
#endif
    PH(13) { t4_final(R2, args.out, in_ptr(22), gw, NGW, lane_id()); }
#if defined(MLPROBE_SEG) || defined(ATPROBE_SEG)
    if (blockIdx.x == 0 && tid == 0) { const unsigned long long span = *(volatile LAS unsigned*)(L + 163840 - 64), t2 = __builtin_amdgcn_s_memrealtime(); while (__builtin_amdgcn_s_memrealtime() - t2 < 9ull * span) __builtin_amdgcn_s_sleep(32); }
#endif
#ifdef PROBE_EPI
    if (blockIdx.x == 0 && tid == 0) { const unsigned long long span = *(volatile LAS unsigned*)(L + MISC_OFF + 64), t2 = __builtin_amdgcn_s_memrealtime(); while (__builtin_amdgcn_s_memrealtime() - t2 < 9ull * span) __builtin_amdgcn_s_sleep(32); }
#endif
#ifdef PROBE_ATT
    xcd_barrier(bar); pt0 = __builtin_amdgcn_s_memrealtime();
    for (int g = vcu; g < NSEQ * 8 * 16; g += G) { const int bh = g >> 4, qb = g & 15, sq = bh >> 3, hh = bh & 7; att::attn_unit<PROBE_ATT>(R1, R2, R3, KR, R5, R1, sq * SEQ, qb, hh, (char*)lds); }
    xcd_barrier(bar); pt1 = __builtin_amdgcn_s_memrealtime();
#endif
#ifdef PROBE_DUMMY
    xcd_barrier(bar); pt0 = __builtin_amdgcn_s_memrealtime();
#ifdef PROBE_K2816
    { FPlain f{R4}; run_gemm<FPlain, 0, 44>(L, DUMPW, R2, (const bf16*)(ws + WS_WDN), 1024, DFF, G, f, 0, false, PROBE_DUMMY); }
#elif defined(PROBE_LINSTORE)
    { FLin f{R4}; run_gemm<FLin, 0, 16>(L, DUMPW, R1, (const bf16*)(ws + WS_WPG), 1024, 1024, G, f, 0, false, PROBE_DUMMY); }
#elif defined(PROBE_NOSTORE)
    { FNone f{R4}; run_gemm<FNone, 0, 16>(L, DUMPW, R1, (const bf16*)(ws + WS_WPG), 1024, 1024, G, f, 0, false, PROBE_DUMMY); }
#else
    { FPlain f{R4}; run_gemm<FPlain, 0, 16>(L, DUMPW, R1, (const bf16*)(ws + WS_WPG), 1024, 1024, G, f, 0, false, PROBE_DUMMY); }
#endif
    xcd_barrier(bar); pt1 = __builtin_amdgcn_s_memrealtime();
#endif
#ifdef PROBE_LO
    if (PROBE_LO == 0) pt0 = 0;
    if (blockIdx.x == 0 && tid == 0) { const unsigned long long span = pt1 - pt0, t2 = __builtin_amdgcn_s_memrealtime(); while (__builtin_amdgcn_s_memrealtime() - t2 < 9ull * span) __builtin_amdgcn_s_sleep(32); }
#endif
#undef PH
#undef SEAM
}

extern "C" void kernel_launch(void* const* d_in, const int* in_sizes, int n_in, void* d_out, int out_size, void* d_ws, size_t ws_size, hipStream_t stream) {
    static int grid = 0;
    if (grid == 0) {
        if (n_in != 23 || in_sizes[0] != MP * DM || out_size != M * DM || ws_size < WS_END) {
            fprintf(stderr, "kernel_launch: unexpected shapes: n_in %d in0 %d out %d ws %zu (need %zu); nothing launched\n", n_in, n_in > 0 ? in_sizes[0] : -1, out_size, ws_size, (size_t)WS_END); grid = -1; return; }
        int dev = 0, cus = 0, per_cu = 0;
        if (hipGetDevice(&dev) != hipSuccess || hipDeviceGetAttribute(&cus, hipDeviceAttributeMultiprocessorCount, dev) != hipSuccess) { fprintf(stderr, "kernel_launch: device query failed\n"); grid = -1; return; }
        if (hipFuncSetAttribute((const void*)fwd_kernel, hipFuncAttributeMaxDynamicSharedMemorySize, LDS_BYTES) != hipSuccess) { fprintf(stderr, "kernel_launch: hipFuncSetAttribute failed\n"); grid = -1; return; }
        if (hipOccupancyMaxActiveBlocksPerMultiprocessor(&per_cu, (const void*)fwd_kernel, NWAVES * 64, LDS_BYTES) != hipSuccess || per_cu < 1)
            fprintf(stderr, "kernel_launch: note: occupancy query reports %d workgroups per CU\n", per_cu);
        (void)hipGetLastError();
        grid = cus;
    }
    if (grid < 0) return;
    if (hipMemsetAsync((char*)d_ws + WS_CTL, 0, CTL_ZERO_BYTES, stream) != hipSuccess) { fprintf(stderr, "kernel_launch: memset failed\n"); return; }
    Args a{};
    for (int i = 0; i < 23; ++i) a.in[i] = (const float*)d_in[i];
    a.out = (float*)d_out; a.ws = (unsigned char*)d_ws;
    for (int li = 0; li < MK_N_LAUNCHES; ++li) {
        a.ph_lo = (MK_N_LAUNCHES == 1) ? 0 : li; a.ph_hi = (MK_N_LAUNCHES == 1) ? N_PHASES : li + 1;
        hipLaunchKernelGGL(fwd_kernel, dim3(grid), dim3(NWAVES * 64), LDS_BYTES, stream, a);
        const hipError_t le = hipPeekAtLastError();
        if (le != hipSuccess) { fprintf(stderr, "kernel_launch: launch failed: %s\n", hipGetErrorName(le)); break; }
    }
}
```
